# Optimizing an MI355X kernel written in HIP

```python
import jax, jax.numpy as jnp
from jax import lax
import numpy as np

D_MODEL = 1024
BATCH = 4
SEQ = 4096
DEPTH = 1

D_MIX = D_MODEL
D_REC = D_MIX // 2
N_REC_BLOCKS = 8
REC_BLOCK = D_REC // N_REC_BLOCKS
CONV_WIDTH = 4
RGLRU_C = 8.0
D_ATT = D_MIX - D_REC
HEAD_DIM = 64
N_HEADS = D_ATT // HEAD_DIM
Q_BLOCK = 128
D_IN_PROJ = 2 * D_REC + 3 * D_ATT + N_HEADS
N_EXPERTS = 32
TOP_K = 4
D_EXPERT = D_MODEL
SWIGLU_LIMIT = 7.0
SWIGLU_ALPHA = 1.702
EXPERT_BLOCK = 128
EPS = 1e-6

kernel_name = "hybrid_rglru_fox_moe_layer"


def _rmsnorm(x, w):
    xf = x.astype(jnp.float32)
    y = xf * lax.rsqrt(jnp.mean(xf * xf, axis=-1, keepdims=True) + EPS)
    return (y * w.astype(jnp.float32)).astype(x.dtype)


def _rg_lru_group(u, gate, conv_w, conv_b, w_a, b_a, w_i, b_i, lam):
    B, S, _ = u.shape
    f32 = jnp.float32
    up = jnp.pad(u, ((0, 0), (CONV_WIDTH - 1, 0), (0, 0)))
    xc = conv_b + up[:, 0:S] * conv_w[0]
    for tap in range(1, CONV_WIDTH):
        xc = xc + up[:, tap:tap + S] * conv_w[tap]
    xb = xc.reshape(B, S, N_REC_BLOCKS, REC_BLOCK)
    r = jax.nn.sigmoid(jnp.einsum('bsgi,gij->bsgj', xb, w_a).reshape(B, S, D_REC) + b_a)
    i = jax.nn.sigmoid(jnp.einsum('bsgi,gij->bsgj', xb, w_i).reshape(B, S, D_REC) + b_i)
    log_a = -RGLRU_C * r.astype(f32) * jax.nn.softplus(-lam.astype(f32))
    a = jnp.exp(log_a)
    b = jnp.sqrt(-jnp.expm1(2.0 * log_a)) * (i * xc).astype(f32)

    def combine(left, right):
        a_l, b_l = left
        a_r, b_r = right
        return a_l * a_r, a_r * b_l + b_r

    _, h = lax.associative_scan(combine, (a, b), axis=1)
    return (h * jax.nn.gelu(gate.astype(f32))).astype(u.dtype)


def _forgetting_attention(q, k, v, f_logit, b_f, q_norm_w, k_norm_w):
    B, S, _ = q.shape
    f32 = jnp.float32
    q = _rmsnorm(q.reshape(B, S, N_HEADS, HEAD_DIM), q_norm_w).astype(f32)
    k = _rmsnorm(k.reshape(B, S, N_HEADS, HEAD_DIM), k_norm_w).astype(f32)
    v = v.reshape(B, S, N_HEADS, HEAD_DIM).astype(f32)
    log_f = jax.nn.log_sigmoid(f_logit.astype(f32) + b_f.astype(f32))
    c = jnp.cumsum(log_f, axis=1)
    c_k = jnp.transpose(c, (0, 2, 1))
    n_blocks = S // Q_BLOCK
    q_blocks = q.reshape(B, n_blocks, Q_BLOCK, N_HEADS, HEAD_DIM).transpose(1, 0, 2, 3, 4)
    c_blocks = c_k.reshape(B, N_HEADS, n_blocks, Q_BLOCK).transpose(2, 0, 1, 3)
    k_pos = jnp.arange(S)
    scale = HEAD_DIM ** -0.5

    def one_block(args):
        q_blk, c_q, blk = args
        logits = jnp.einsum('bqhd,bkhd->bhqk', q_blk, k) * scale + (c_q[..., :, None] - c_k[:, :, None, :])
        q_pos = blk * Q_BLOCK + jnp.arange(Q_BLOCK)
        causal = q_pos[:, None] >= k_pos[None, :]
        p = jax.nn.softmax(jnp.where(causal, logits, -jnp.inf), axis=-1)
        return jnp.einsum('bhqk,bkhd->bqhd', p, v)

    o = lax.map(one_block, (q_blocks, c_blocks, jnp.arange(n_blocks)))
    return o.transpose(1, 0, 2, 3, 4).reshape(B, S, D_ATT)


def _moe(h, w_router, b_router, w_gate_up, b_gate_up, w_down, b_down):
    B, S, D = h.shape
    f32 = jnp.float32
    T = B * S
    A = T * TOP_K
    xt = h.reshape(T, D)
    logits = (xt @ w_router + b_router).astype(f32)
    top_vals, top_idx = lax.top_k(logits, TOP_K)
    gates = jax.nn.softmax(top_vals, axis=-1)
    flat_e = top_idx.reshape(A)
    order = jnp.argsort(flat_e)
    sorted_e = flat_e[order]
    token = order // TOP_K
    gate_sorted = gates.reshape(A)[order]
    counts = jnp.bincount(flat_e, length=N_EXPERTS)
    group_start = jnp.cumsum(counts) - counts
    padded = (counts + EXPERT_BLOCK - 1) // EXPERT_BLOCK * EXPERT_BLOCK
    pad_end = jnp.cumsum(padded)
    pad_start = pad_end - padded
    dest = pad_start[sorted_e] + jnp.arange(A) - group_start[sorted_e]
    n_blocks = -(-A // EXPERT_BLOCK) + N_EXPERTS
    xs = jnp.zeros((n_blocks * EXPERT_BLOCK, D), xt.dtype).at[dest].set(xt[token])
    block_expert = jnp.minimum(
        jnp.searchsorted(pad_end, jnp.arange(n_blocks) * EXPERT_BLOCK, side='right'), N_EXPERTS - 1)

    def expert_block(args):
        x_blk, e = args
        gu = x_blk @ w_gate_up[e] + b_gate_up[e]
        g = jnp.minimum(gu[:, :D_EXPERT], SWIGLU_LIMIT)
        u = jnp.clip(gu[:, D_EXPERT:], -SWIGLU_LIMIT, SWIGLU_LIMIT)
        act = (u + 1.0) * (g * jax.nn.sigmoid(SWIGLU_ALPHA * g))
        return act @ w_down[e] + b_down[e]

    ys = lax.map(expert_block, (xs.reshape(n_blocks, EXPERT_BLOCK, D), block_expert))
    y = ys.reshape(-1, D)[dest].astype(f32) * gate_sorted[:, None]
    out = jax.ops.segment_sum(y, token, num_segments=T)
    return out.reshape(B, S, D).astype(h.dtype)


def setup_inputs(seed: int = 0) -> dict:
    key = jax.random.key(seed)
    ks = jax.random.split(key, 24)
    f32 = jnp.float32
    L = DEPTH

    def nrm(k, shape, scale):
        return jax.random.normal(k, shape, f32) * scale

    a0 = jax.random.uniform(ks[9], (L, D_REC), f32, 0.9, 0.999)
    sig = a0 ** (1.0 / RGLRU_C)
    rg_lambda = jnp.log(sig) - jnp.log1p(-sig)
    return {
        "x": nrm(ks[0], (BATCH, SEQ, D_MODEL), 1.0),
        "ln1_w": 1.0 + nrm(ks[1], (L, D_MODEL), 0.02),
        "w_in": nrm(ks[2], (L, D_MODEL, D_IN_PROJ), D_MODEL ** -0.5),
        "conv_w": nrm(ks[3], (L, CONV_WIDTH, D_REC), CONV_WIDTH ** -0.5),
        "conv_b": nrm(ks[4], (L, D_REC), 0.02),
        "w_rg_a": nrm(ks[5], (L, N_REC_BLOCKS, REC_BLOCK, REC_BLOCK), REC_BLOCK ** -0.5),
        "b_rg_a": nrm(ks[6], (L, D_REC), 0.02),
        "w_rg_i": nrm(ks[7], (L, N_REC_BLOCKS, REC_BLOCK, REC_BLOCK), REC_BLOCK ** -0.5),
        "b_rg_i": nrm(ks[8], (L, D_REC), 0.02),
        "rg_lambda": rg_lambda,
        "b_forget": jax.random.uniform(ks[10], (L, N_HEADS), f32, 1.0, 4.0),
        "q_norm_w": 1.0 + nrm(ks[11], (L, HEAD_DIM), 0.02),
        "k_norm_w": 1.0 + nrm(ks[12], (L, HEAD_DIM), 0.02),
        "rec_out_norm_w": 1.0 + nrm(ks[13], (L, D_REC), 0.02),
        "attn_out_norm_w": 1.0 + nrm(ks[14], (L, D_ATT), 0.02),
        "w_out": nrm(ks[15], (L, D_MIX, D_MODEL), D_MIX ** -0.5),
        "ln2_w": 1.0 + nrm(ks[16], (L, D_MODEL), 0.02),
        "w_router": nrm(ks[17], (L, D_MODEL, N_EXPERTS), D_MODEL ** -0.5),
        "b_router": nrm(ks[18], (L, N_EXPERTS), 0.01),
        "w_gate_up": nrm(ks[19], (L, N_EXPERTS, D_MODEL, 2 * D_EXPERT), D_MODEL ** -0.5),
        "b_gate_up": nrm(ks[20], (L, N_EXPERTS, 2 * D_EXPERT), 0.02),
        "w_down": nrm(ks[21], (L, N_EXPERTS, D_EXPERT, D_MODEL), D_EXPERT ** -0.5),
        "b_down": nrm(ks[22], (L, N_EXPERTS, D_MODEL), 0.02),
    }


def reference(x, ln1_w, w_in, conv_w, conv_b, w_rg_a, b_rg_a, w_rg_i, b_rg_i, rg_lambda, b_forget,
              q_norm_w, k_norm_w, rec_out_norm_w, attn_out_norm_w, w_out, ln2_w, w_router, b_router,
              w_gate_up, b_gate_up, w_down, b_down):
    o_q = 2 * D_REC
    o_k = o_q + D_ATT
    o_v = o_k + D_ATT
    o_f = o_v + D_ATT
    for l in range(DEPTH):
        h = _rmsnorm(x, ln1_w[l])
        proj = jnp.einsum('bsd,de->bse', h, w_in[l])
        u = proj[..., :D_REC]
        gate = proj[..., D_REC:o_q]
        q = proj[..., o_q:o_k]
        k = proj[..., o_k:o_v]
        v = proj[..., o_v:o_f]
        f_logit = proj[..., o_f:]
        rec = _rg_lru_group(u, gate, conv_w[l], conv_b[l], w_rg_a[l], b_rg_a[l],
                            w_rg_i[l], b_rg_i[l], rg_lambda[l])
        att = _forgetting_attention(q, k, v, f_logit, b_forget[l], q_norm_w[l], k_norm_w[l])
        mix = jnp.concatenate([_rmsnorm(rec, rec_out_norm_w[l]).astype(x.dtype),
                               _rmsnorm(att, attn_out_norm_w[l]).astype(x.dtype)], axis=-1)
        x = x + jnp.einsum('bse,ed->bsd', mix, w_out[l])
        x = x + _moe(_rmsnorm(x, ln2_w[l]), w_router[l], b_router[l], w_gate_up[l], b_gate_up[l],
                     w_down[l], b_down[l])
    return x
```

```cpp
#include <hip/hip_runtime.h>
#include <cstdio>
#include <cstdint>
namespace pg8 {
#define PG8_LAS __attribute__((address_space(3)))
typedef unsigned short bf16_t;
typedef short bf16x8 __attribute__((ext_vector_type(8)));
typedef float f32x4 __attribute__((ext_vector_type(4)));
typedef unsigned u32x4 __attribute__((ext_vector_type(4)));
constexpr int BM = 256, BK = 64, HALF = 128, HTB = HALF * BK * 2  , STAGE_BYTES = 8 * HTB, NXCD = 8, WGM = 8;

__host__ __device__ __forceinline__ int lds_byte(int r, int c) { const int st = (r >> 4) * 2 + (c >> 5), rr = r & 15, cc = c & 31, ob = rr * 64 + cc * 2; return st * 1024 + (ob ^ (((ob >> 9) & 1) << 5)); }
__host__ __device__ __forceinline__ void stage_rc(int b, int& R, int& C) { const int st = b / 1024, sb = b % 1024, swz = sb ^ (((sb >> 9) & 1) << 5); R = (st >> 1) * 16 + swz / 64; C = (st & 1) * 32 + (swz % 64) / 2; }
__host__ __device__ __forceinline__ int perm32(int rho) { const int n = rho >> 4, i = rho & 15; return 8 * (i >> 2) + 4 * n + (i & 3); }

struct Unit { int pm, pn; };
struct Gemm { const bf16_t* A; const bf16_t* Bt; int M, N, K; };

struct StaticOrder {
    int nM, nN, nwg, G, c;
    __host__ __device__ void init(int M, int N, int G_, int c_) { nM = M / BM; nN = N / BM; nwg = nM * nN; G = G_; c = c_; }
    __host__ __device__ bool next(int i, Unit& u) const {
        const long L = (long)i * G + c; if (L >= nwg) return false;
        int wgid = (int)L; { const int q = nwg / NXCD, r = nwg % NXCD, xcd = wgid % NXCD, off = wgid / NXCD; wgid = (xcd < r ? xcd * (q + 1) : r * (q + 1) + (xcd - r) * q) + off; }
        const int nig = WGM * nN, gid = wgid / nig, fm = gid * WGM, gsz = (nM - fm) < WGM ? (nM - fm) : WGM;
        u.pm = fm + ((wgid % nig) % gsz); u.pn = (wgid % nig) / gsz; return true;
    }
    __device__ __forceinline__ void a_ready(const Unit&) const {}
    __device__ __forceinline__ void done(const Unit&) const {}
};

__device__ __forceinline__ unsigned cvt_pk_bf16(float lo, float hi) { unsigned r; asm volatile("v_cvt_pk_bf16_f32 %0, %1, %2" : "=v"(r) : "v"(lo), "v"(hi)); return r; }
template <class Epi, class Sched, bool ALIGN_EPI = false, bool SP2 = false>
__device__ __forceinline__ void gemm_phase(PG8_LAS unsigned char* lds, const Gemm g, const Sched& S, const Epi& E) {
    const int tid = threadIdx.x, wid = __builtin_amdgcn_readfirstlane(tid >> 6), lane = tid & 63, wr = wid >> 2, wc = wid & 3, fr = lane & 15, fq = lane >> 4;
    const int K = g.K, nt = K / BK;
    unsigned voffA[2], voffB[2];
#pragma unroll
    for (int i = 0; i < 2; ++i) { int R, C; stage_rc(tid * 16 + i * 8192, R, C); const int Rb = Epi::PERM ? ((R & ~31) + perm32(R & 31)) : R;
        voffA[i] = (unsigned)(R * K + C) * 2u; voffB[i] = (unsigned)(Rb * K + C) * 2u; }
    const size_t kstep = (size_t)(BK * 2);
    const size_t hstep = (size_t)HALF * K * 2;
    const size_t tstep = 2 * hstep;
    const unsigned ldsw = (unsigned)wid * 1024u;
    const int aoff = lds_byte(wr * 64 + fr, fq * 8), boff = lds_byte(wc * 32 + fr, fq * 8);
#define PG8_SA(b, h) (((b) * 2 + (h)) * HTB)
#define PG8_SB(b, h) ((4 + (b) * 2 + (h)) * HTB)
#define PG8_STAGE(bufoff, gbase, voff) do { _Pragma("unroll") for (int _i = 0; _i < 2; ++_i) \
        __builtin_amdgcn_global_load_lds((const unsigned*)((const char*)(gbase) + (voff)[_i]), (PG8_LAS unsigned*)(lds + (bufoff) + ldsw + _i * 8192), 16, 0, 0); } while (0)
#define PG8_LDA(dst, b, h) do { _Pragma("unroll") for (int m = 0; m < 4; ++m) _Pragma("unroll") for (int k = 0; k < 2; ++k) dst[m][k] = *(const PG8_LAS bf16x8*)(lds + PG8_SA(b, h) + aoff + m * 2048 + k * 1024); } while (0)
#define PG8_LDB(dst, b, h) do { _Pragma("unroll") for (int n = 0; n < 2; ++n) _Pragma("unroll") for (int k = 0; k < 2; ++k) dst[n][k] = *(const PG8_LAS bf16x8*)(lds + PG8_SB(b, h) + boff + n * 2048 + k * 1024); } while (0)
#define PG8_MMA(ai, bj, At, Bt) do { __builtin_amdgcn_s_setprio(1); _Pragma("unroll") for (int m = 0; m < 4; ++m) _Pragma("unroll") for (int n = 0; n < 2; ++n) _Pragma("unroll") for (int k = 0; k < 2; ++k) \
        acc[ai][bj][m][n] = __builtin_amdgcn_mfma_f32_16x16x32_bf16(Bt[n][k], At[m][k], acc[ai][bj][m][n], 0, 0, 0); __builtin_amdgcn_s_setprio(0); } while (0)
#define PG8_WAIT_V(n) asm volatile("s_waitcnt vmcnt(" #n ")" ::: "memory")
#define PG8_WAIT_L(n) asm volatile("s_waitcnt lgkmcnt(" #n ")" ::: "memory")
#define PG8_BAR __builtin_amdgcn_s_barrier()
#define PG8_SCHED __builtin_amdgcn_sched_barrier(0)
    Unit cur, nxt; int ui = 0;
    if (!S.next(0, cur)) return;
    f32x4 acc[2][2][4][2];
#pragma unroll
    for (int a = 0; a < 2; ++a)
#pragma unroll
        for (int b = 0; b < 2; ++b)
#pragma unroll
            for (int m = 0; m < 4; ++m)
#pragma unroll
                for (int n = 0; n < 2; ++n) acc[a][b][m][n] = (f32x4){0.f, 0.f, 0.f, 0.f};
    bf16x8 At[4][2], B0[2][2], B1[2][2];
    const char* cA = (const char*)g.A + (size_t)cur.pm * tstep; const char* cB = (const char*)g.Bt + (size_t)cur.pn * tstep;
    S.a_ready(cur);
    if constexpr (SP2) {
        PG8_STAGE(PG8_SB(0, 0), cB, voffB); PG8_STAGE(PG8_SB(0, 1), cB + hstep, voffB); PG8_STAGE(PG8_SA(0, 0), cA, voffA); PG8_STAGE(PG8_SA(0, 1), cA + hstep, voffA);
        if (wr == 1) PG8_BAR;
        PG8_WAIT_V(2); PG8_BAR;
        PG8_STAGE(PG8_SB(1, 0), cB + kstep, voffB); PG8_STAGE(PG8_SA(1, 0), cA + kstep, voffA); PG8_STAGE(PG8_SB(1, 1), cB + hstep + kstep, voffB);
        PG8_WAIT_V(6); PG8_BAR;
    } else {
        PG8_STAGE(PG8_SB(0, 0), cB, voffB); PG8_STAGE(PG8_SA(0, 0), cA, voffA); PG8_STAGE(PG8_SB(0, 1), cB + hstep, voffB); PG8_STAGE(PG8_SA(0, 1), cA + hstep, voffA);
        if (wr == 1) PG8_BAR;
        PG8_WAIT_V(4); PG8_BAR;
        PG8_STAGE(PG8_SB(1, 0), cB + kstep, voffB); PG8_STAGE(PG8_SA(1, 0), cA + kstep, voffA); PG8_STAGE(PG8_SB(1, 1), cB + hstep + kstep, voffB);
        PG8_WAIT_V(6); PG8_BAR;
    }
    for (;;) {
        const bool has_next = S.next(ui + 1, nxt);
        const char* nA = has_next ? (const char*)g.A + (size_t)nxt.pm * tstep : cA; const char* nB = has_next ? (const char*)g.Bt + (size_t)nxt.pn * tstep : cB;
        for (int t = 0; t < nt; t += 2) {
            const bool last = (t == nt - 2);
            const char* a1 = cA + (size_t)(t + 1) * kstep;
            const char* a2 = last ? nA : cA + (size_t)(t + 2) * kstep; const char* b2 = last ? nB : cB + (size_t)(t + 2) * kstep;
            const char* a3 = a2 + kstep; const char* b3 = b2 + kstep;
            if (last && has_next) S.a_ready(nxt);
            if constexpr (SP2) {
            PG8_LDB(B0, 0, 0); PG8_LDB(B1, 0, 1); PG8_SCHED; PG8_LDA(At, 0, 0); PG8_STAGE(PG8_SA(1, 1), a1 + hstep, voffA);
            PG8_WAIT_V(8); PG8_WAIT_L(0); PG8_BAR; PG8_MMA(0, 0, At, B0); PG8_MMA(0, 1, At, B1); PG8_BAR; PG8_SCHED;
            PG8_LDA(At, 0, 1); PG8_STAGE(PG8_SB(0, 0), b2, voffB); PG8_STAGE(PG8_SB(0, 1), b2 + hstep, voffB); PG8_STAGE(PG8_SA(0, 0), a2, voffA);
            PG8_WAIT_V(8); PG8_WAIT_L(0); PG8_BAR; PG8_MMA(1, 0, At, B0); PG8_MMA(1, 1, At, B1); PG8_BAR; PG8_SCHED;
            PG8_LDB(B0, 1, 0); PG8_LDB(B1, 1, 1); PG8_SCHED; PG8_LDA(At, 1, 0); PG8_STAGE(PG8_SA(0, 1), a2 + hstep, voffA);
            PG8_WAIT_V(8); PG8_WAIT_L(0); PG8_BAR; PG8_MMA(0, 0, At, B0); PG8_MMA(0, 1, At, B1); PG8_BAR; PG8_SCHED;
            PG8_LDA(At, 1, 1); PG8_STAGE(PG8_SB(1, 0), b3, voffB); PG8_STAGE(PG8_SB(1, 1), b3 + hstep, voffB); PG8_STAGE(PG8_SA(1, 0), a3, voffA);
            PG8_WAIT_V(8); PG8_WAIT_L(0); PG8_BAR; PG8_MMA(1, 0, At, B0); PG8_MMA(1, 1, At, B1); PG8_BAR; PG8_SCHED;
            } else {
            PG8_LDB(B0, 0, 0); PG8_SCHED; PG8_LDA(At, 0, 0); PG8_STAGE(PG8_SA(1, 1), a1 + hstep, voffA);
            PG8_WAIT_L(8); PG8_BAR; PG8_WAIT_L(0); PG8_MMA(0, 0, At, B0); PG8_BAR; PG8_SCHED;
            PG8_LDB(B1, 0, 1); PG8_STAGE(PG8_SB(0, 0), b2, voffB);
            PG8_BAR; PG8_WAIT_L(0); PG8_MMA(0, 1, At, B1); PG8_BAR;
            PG8_LDA(At, 0, 1); PG8_STAGE(PG8_SA(0, 0), a2, voffA);
            PG8_BAR; PG8_WAIT_L(0); PG8_MMA(1, 0, At, B0); PG8_BAR; PG8_SCHED;
            PG8_STAGE(PG8_SB(0, 1), b2 + hstep, voffB);
            PG8_WAIT_V(6); PG8_BAR; PG8_MMA(1, 1, At, B1); PG8_BAR;
            PG8_LDB(B0, 1, 0); PG8_SCHED; PG8_LDA(At, 1, 0); PG8_STAGE(PG8_SA(0, 1), a2 + hstep, voffA);
            PG8_WAIT_L(8); PG8_BAR; PG8_WAIT_L(0); PG8_MMA(0, 0, At, B0); PG8_BAR; PG8_SCHED;
            PG8_LDB(B1, 1, 1); PG8_STAGE(PG8_SB(1, 0), b3, voffB);
            PG8_BAR; PG8_WAIT_L(0); PG8_MMA(0, 1, At, B1); PG8_BAR;
            PG8_LDA(At, 1, 1); PG8_STAGE(PG8_SA(1, 0), a3, voffA);
            PG8_BAR; PG8_WAIT_L(0); PG8_MMA(1, 0, At, B0); PG8_BAR; PG8_SCHED;
            PG8_STAGE(PG8_SB(1, 1), b3 + hstep, voffB);
            PG8_WAIT_V(6); PG8_BAR; PG8_MMA(1, 1, At, B1); PG8_BAR;
            }
        }
        if constexpr (ALIGN_EPI) { if (wr == 0) PG8_BAR; }
        if constexpr (!Epi::AFTER_DRAIN) { E(acc, cur, wr, wc, fr, fq); S.done(cur); }
        if (!has_next) break;
#pragma unroll
        for (int a = 0; a < 2; ++a)
#pragma unroll
            for (int b = 0; b < 2; ++b)
#pragma unroll
                for (int m = 0; m < 4; ++m)
#pragma unroll
                    for (int n = 0; n < 2; ++n) acc[a][b][m][n] = (f32x4){0.f, 0.f, 0.f, 0.f};
        cur = nxt; cA = nA; cB = nB; ++ui;
        if constexpr (ALIGN_EPI) { if (wr == 1) PG8_BAR; }
    }
    PG8_WAIT_V(0);
    if constexpr (!ALIGN_EPI) { if (wr == 0) PG8_BAR; }
    PG8_BAR;
    if constexpr (Epi::AFTER_DRAIN) { E.fused(acc, cur, wr, wc, fr, fq, lds, wid, lane); S.done(cur); }
#undef PG8_SA
#undef PG8_SB
#undef PG8_STAGE
#undef PG8_LDA
#undef PG8_LDB
#undef PG8_MMA
#undef PG8_WAIT_V
#undef PG8_WAIT_L
#undef PG8_BAR
#undef PG8_SCHED
}
}
#define GAS __attribute__((address_space(1)))
#define LAS __attribute__((address_space(3)))
typedef unsigned short bf16;
typedef unsigned v4u __attribute__((ext_vector_type(4)));
typedef float f32x4 __attribute__((ext_vector_type(4)));
typedef short bf16x8 __attribute__((ext_vector_type(8)));
typedef GAS unsigned gu32;
typedef GAS unsigned long long gu64;
#define RLX_AGENT __ATOMIC_RELAXED, __HIP_MEMORY_SCOPE_AGENT
#define LDS_WAIT() asm volatile("s_waitcnt lgkmcnt(0)" ::: "memory")
#define VM_WAIT() asm volatile("s_waitcnt vmcnt(0)" ::: "memory")
__device__ __forceinline__ unsigned long long rt() { return __builtin_amdgcn_s_memrealtime(); }
__device__ __forceinline__ unsigned f2bf(float f) { unsigned u = __builtin_bit_cast(unsigned, f); return (u + 0x7fffu + ((u >> 16) & 1u)) >> 16; }
__device__ __forceinline__ unsigned pk2(float lo, float hi) { return f2bf(lo) | (f2bf(hi) << 16); }

#define XB_TMO      128
#define XB_XCNT(j)  (256  + 64 * (j))
#define XB_XSUB(j)  (1280 + 64 * (j))
#define XB_XGEN(j)  (2304 + 64 * (j))
#define XB_TOP      3328
#define XB_TOPGEN   3392
#define XCD_BAR_WORDS 3456
#define XB_SPIN_CAP (1u << 18)

__device__ __forceinline__ unsigned xb_ld(unsigned* p)              { return __hip_atomic_load(p, __ATOMIC_RELAXED, __HIP_MEMORY_SCOPE_AGENT); }
__device__ __forceinline__ unsigned xb_add(unsigned* p, unsigned v) { return __hip_atomic_fetch_add(p, v, __ATOMIC_RELAXED, __HIP_MEMORY_SCOPE_AGENT); }
__device__ __forceinline__ unsigned xb_xcc_id() { return (unsigned)__builtin_amdgcn_s_getreg((3 << 11) | 20) & 0xFu; }
#define XB_SPIN(cond, bar) do { unsigned _sp = 0; while (cond) { __builtin_amdgcn_s_sleep(1); \
    if ((++_sp & 255u) == 0u) { if (xb_ld(&(bar)[XB_TMO])) break; if (_sp > XB_SPIN_CAP) { atomicAdd(&(bar)[XB_TMO], 1u); break; } } } } while (0)

struct XcdBarrier {
    unsigned* bar; unsigned x;
    volatile LAS unsigned* st;
};

__device__ __forceinline__ XcdBarrier xcd_barrier_post(unsigned* bar, volatile LAS unsigned* st) {
    XcdBarrier b; b.bar = bar; b.x = xb_xcc_id(); b.st = st;
    if (threadIdx.x == 0) (void)xb_add(&bar[XB_XCNT(b.x)], 1u);
    return b;
}
__device__ __forceinline__ void xcd_barrier_complete(unsigned* bar, unsigned x, unsigned& nloc, unsigned& nx) {
    const unsigned G = gridDim.x * gridDim.y * gridDim.z;
    unsigned sum, cnt, mine, sp = 0u;
    for (;;) {
        sum = 0u; cnt = 0u; mine = 0u;
#pragma unroll
        for (unsigned j = 0; j < 16; ++j) { const unsigned c = xb_ld(&bar[XB_XCNT(j)]); sum += c; cnt += (c > 0u) ? 1u : 0u; mine = (j == x) ? c : mine; }
        if (sum == G) break;
        __builtin_amdgcn_s_sleep(1);
        if ((++sp & 255u) == 0u) { if (xb_ld(&bar[XB_TMO])) break; if (sp > XB_SPIN_CAP) { atomicAdd(&bar[XB_TMO], 1u); break; } }
    }
    nloc = mine > 0u ? mine : 1u; nx = cnt > 0u ? cnt : 1u;
}

__device__ __forceinline__ void xcd_barrier(const XcdBarrier& b) {
    asm volatile("s_waitcnt vmcnt(0)" ::: "memory");
    __syncthreads();
    if (threadIdx.x == 0) {
        unsigned* bar = b.bar;
        __builtin_amdgcn_s_waitcnt(0);
        unsigned nloc = b.st[0], nx = b.st[1];
        if (nloc == 0u) { xcd_barrier_complete(bar, b.x, nloc, nx); b.st[0] = nloc; b.st[1] = nx; }
        const unsigned old = xb_add(&bar[XB_XSUB(b.x)], 1u);
        const unsigned gen = old / nloc;
        if (old + 1u == (gen + 1u) * nloc) {
            __builtin_amdgcn_fence(__ATOMIC_RELEASE, "agent");
            asm volatile("s_waitcnt vmcnt(0)" ::: "memory");
            const unsigned og = xb_add(&bar[XB_TOP], 1u);
            const unsigned tg = og / nx;
            if (og + 1u == (tg + 1u) * nx) xb_add(&bar[XB_TOPGEN], 1u);
            else XB_SPIN(xb_ld(&bar[XB_TOPGEN]) == tg, bar);
            __builtin_amdgcn_fence(__ATOMIC_ACQUIRE, "agent");
            xb_add(&bar[XB_XGEN(b.x)], 1u);
            asm volatile("s_waitcnt vmcnt(0)" ::: "memory");
        } else {
            XB_SPIN(xb_ld(&bar[XB_XGEN(b.x)]) == gen, bar);
            __builtin_amdgcn_fence(__ATOMIC_ACQUIRE, "agent");
            asm volatile("s_waitcnt vmcnt(0)" ::: "memory");
        }
    }
    __syncthreads();
}


constexpr int NWAVES = 8;
#ifndef MK_N_LAUNCHES
#define MK_N_LAUNCHES 10
#endif
constexpr int PER_PHASE = 10;
constexpr int N_LAUNCHES = MK_N_LAUNCHES;

constexpr int BATCH = 4, SEQ = 4096, DM = 1024, M = BATCH * SEQ;
constexpr int DREC = 512, DATT = 512, NH = 8, HD = 64;
constexpr int NPROJ = 2560, LDW_IN = 2568;
constexpr int NE = 32, TOPK = 4;
constexpr int MAXSLOT = M * TOPK + NE * 256, MAXMT = MAXSLOT / 256;
constexpr int CHUNK = 64, NCHUNK = SEQ / CHUNK;
constexpr float EPS = 1e-6f;
constexpr float LOG2E = 1.4426950408889634f;
constexpr float QSCALE = 0.125f * LOG2E;

constexpr size_t MiB = 1u << 20;
constexpr size_t WS_CTL = 0, CTL_ZERO_BYTES = 1 * MiB;
constexpr size_t WS_WIN = 2 * MiB, WS_WOUT = 8 * MiB;
constexpr size_t WS_LOGF = 10 * MiB, WS_C2 = WS_LOGF + 512 * 1024, WS_AEND = 11 * MiB, WS_BEND = WS_AEND + 512 * 1024;
constexpr size_t WS_RSTD2 = 12 * MiB, WS_TKE = WS_RSTD2 + 256 * 1024, WS_TKP = WS_TKE + 256 * 1024, WS_TKG = WS_TKP + 256 * 1024, WS_SLOTG = 13 * MiB;
constexpr size_t WS_WGU = 16 * MiB, WS_WDN = 144 * MiB, WS_XN = 208 * MiB;
constexpr size_t WS_U = 240 * MiB, WS_GG = 256 * MiB, WS_Q = 272 * MiB, WS_K = 288 * MiB, WS_V = 304 * MiB, WS_ATT = 320 * MiB;
constexpr size_t WS_HLOC = 336 * MiB, WS_PC = 368 * MiB, WS_MIX = 400 * MiB, WS_XS = 432 * MiB, WS_HB = 576 * MiB, WS_END = 720 * MiB;
constexpr size_t WS_YS = WS_XS;
constexpr int CW_TMO = 0, CW_BAR = 4096, CW_CNT = 16384;

constexpr int LDS_BYTES = 163840, LDSCTL_OFF = 155648;
constexpr int MISC_OFF = LDSCTL_OFF;
constexpr int TAB_OFF = LDSCTL_OFF + 256;


typedef float f32x16 __attribute__((ext_vector_type(16)));
typedef float f32x2 __attribute__((ext_vector_type(2)));
typedef unsigned u32x2 __attribute__((ext_vector_type(2)));
typedef short s16x4 __attribute__((ext_vector_type(4)));
typedef __bf16 bf16x2_t __attribute__((ext_vector_type(2)));
__device__ __forceinline__ unsigned cvtpk(float lo, float hi) { f32x2 v = {lo, hi}; bf16x2_t b = __builtin_convertvector(v, bf16x2_t); return __builtin_bit_cast(unsigned, b); }
__device__ __forceinline__ float bflo(unsigned w) { return __uint_as_float(w << 16); }
__device__ __forceinline__ float bfhi(unsigned w) { return __uint_as_float(w & 0xffff0000u); }
__device__ __forceinline__ float bf2f(bf16 h) { return __uint_as_float((unsigned)h << 16); }
__device__ __forceinline__ float wave_sum(float v) {
#pragma unroll
    for (int o = 1; o < 64; o <<= 1) v += __shfl_xor(v, o);
    return v;
}
__device__ __forceinline__ float wave_max(float v) {
#pragma unroll
    for (int o = 1; o < 64; o <<= 1) v = fmaxf(v, __shfl_xor(v, o));
    return v;
}
__device__ __forceinline__ float fast_exp(float x) { return __builtin_amdgcn_exp2f(x * LOG2E); }
__device__ __forceinline__ float fast_sigmoid(float x) { return __builtin_amdgcn_rcpf(1.0f + fast_exp(-x)); }
__device__ __forceinline__ float gelu_tanh(float x) {
    const float y = 0.7978845608028654f * (x + 0.044715f * x * x * x);
    const float t = 1.0f - 2.0f * __builtin_amdgcn_rcpf(1.0f + fast_exp(2.0f * y));
    return 0.5f * x * (1.0f + t);
}
__device__ __forceinline__ int crow(int r, int hi) { return (r & 3) + 8 * (r >> 2) + 4 * hi; }

struct Ctx {
    LAS unsigned char* lds;
    int tid, lane, wave, vcu, G;
    const float* in[23];
    float* out;
    unsigned char* ws;
};
#define WSP(T, off) ((T*)(C.ws + (off)))

__device__ __forceinline__ void p0_item(const float* W, int ldw, int k0, int src_n0, bf16* WT, int dst_row0, int ldt, LAS float* scr, int lane) {
    f32x4 v[8];
#pragma unroll
    for (int i = 0; i < 8; ++i) v[i] = *(const f32x4*)(W + (size_t)(k0 + i * 8 + (lane >> 3)) * ldw + src_n0 + (lane & 7) * 4);
#pragma unroll
    for (int i = 0; i < 8; ++i) { LAS float* s = scr + (i * 8 + (lane >> 3)) * 33 + (lane & 7) * 4; s[0] = v[i].x; s[1] = v[i].y; s[2] = v[i].z; s[3] = v[i].w; }
    LDS_WAIT(); asm volatile("" ::: "memory");
#pragma unroll
    for (int jj = 0; jj < 4; ++jj) {
        const int n = lane & 31, kc = (lane >> 5) + 2 * jj; const LAS float* s = scr + (8 * kc) * 33 + n;
        v4u o; o.x = cvtpk(s[0], s[33]); o.y = cvtpk(s[66], s[99]); o.z = cvtpk(s[132], s[165]); o.w = cvtpk(s[198], s[231]);
        *(v4u*)(WT + (size_t)(dst_row0 + n) * ldt + k0 + 8 * kc) = o;
    }
    LDS_WAIT(); asm volatile("" ::: "memory");
}
__device__ __forceinline__ int win_src_col(int n_dst) {
    const int pn = n_dst >> 8, c = n_dst & 255;
    if (pn < 4 || pn >= 8) return n_dst;
    const int base = 1024 + (pn - 4) * 256;
    return base + ((c >> 5) & 3) * 64 + (c >> 7) * 32 + (c & 31);
}
__device__ __forceinline__ void p0_prologue(const Ctx& C) {
    LAS float* scr = (LAS float*)(C.lds + C.wave * 8448);
    LAS float* wfT = (LAS float*)(C.lds + 69632);
    const float* w_in = C.in[2];
    for (int idx = C.tid; idx < 8192; idx += NWAVES * 64) { const int d = idx >> 3, j = idx & 7; wfT[j * 1024 + d] = w_in[(size_t)d * LDW_IN + NPROJ + j]; }
    __syncthreads();
    const int gw = C.vcu * NWAVES + C.wave, NGW = C.G * NWAVES;
    {
        const float* x = C.in[0]; const float* ln1 = C.in[1]; const float* bfg = C.in[10];
        bf16* XN = WSP(bf16, WS_XN); float* LOGF = WSP(float, WS_LOGF);
        f32x4 w[4];
#pragma unroll
        for (int jj = 0; jj < 4; ++jj) w[jj] = *(const f32x4*)(ln1 + 4 * C.lane + 256 * jj);
        for (int m = gw; m < M; m += NGW) {
            const f32x4* xr = (const f32x4*)(x + (size_t)m * DM) + C.lane;
            f32x4 v[4]; float ss = 0.f;
#pragma unroll
            for (int jj = 0; jj < 4; ++jj) { v[jj] = xr[64 * jj]; ss += (v[jj].x * v[jj].x + v[jj].y * v[jj].y) + (v[jj].z * v[jj].z + v[jj].w * v[jj].w); }
            const float rstd = 1.0f / sqrtf(wave_sum(ss) * (1.0f / DM) + EPS);
#pragma unroll
            for (int jj = 0; jj < 4; ++jj) v[jj] = v[jj] * rstd * w[jj];
            unsigned long long* o8 = (unsigned long long*)(XN + (size_t)m * DM) + C.lane;
#pragma unroll
            for (int jj = 0; jj < 4; ++jj) o8[64 * jj] = (unsigned long long)cvtpk(v[jj].x, v[jj].y) | ((unsigned long long)cvtpk(v[jj].z, v[jj].w) << 32);
            float f[8];
#pragma unroll
            for (int j = 0; j < 8; ++j) { float a = 0.f;
#pragma unroll
                for (int jj = 0; jj < 4; ++jj) { const f32x4 wv = *(const LAS f32x4*)(wfT + j * 1024 + 4 * C.lane + 256 * jj); a += (v[jj].x * wv.x + v[jj].y * wv.y) + (v[jj].z * wv.z + v[jj].w * wv.w); }
                f[j] = wave_sum(a); }
            float z = f[0];
#pragma unroll
            for (int j = 1; j < 8; ++j) z = (C.lane == j) ? f[j] : z;
            if (C.lane < 8) { z += bfg[C.lane]; const float ls = fminf(z, 0.f) - log1pf(expf(-fabsf(z))); const int b = m >> 12, t = m & 4095; LOGF[(size_t)(b * NH + C.lane) * SEQ + t] = ls; }
        }
    }
    {
        bf16* WIN = WSP(bf16, WS_WIN); bf16* WOUT = WSP(bf16, WS_WOUT); bf16* WGU = WSP(bf16, WS_WGU); bf16* WDN = WSP(bf16, WS_WDN);
        constexpr int I_IN = 16 * 80, I_OUT = 16 * 32, I_GU = NE * 16 * 64, I_DN = NE * 16 * 32, NITEMS = I_IN + I_OUT + I_GU + I_DN;
        for (int it = gw; it < NITEMS; it += NGW) {
            int r = it;
            if (r < I_IN) { const int kb = r / 80, nb = r % 80; p0_item(w_in, LDW_IN, kb * 64, win_src_col(nb * 32), WIN, nb * 32, DM, scr, C.lane); continue; } r -= I_IN;
            if (r < I_OUT) { const int kb = r >> 5, nb = r & 31; p0_item(C.in[15], DM, kb * 64, nb * 32, WOUT, nb * 32, DM, scr, C.lane); continue; } r -= I_OUT;
            if (r < I_GU) { const int e = r >> 10, q = r & 1023, kb = q >> 6, nb = q & 63, pn = nb >> 3, c0 = (nb & 7) * 32;
                const int src = (c0 < 128) ? 128 * pn + c0 : 1024 + 128 * pn + (c0 - 128);
                p0_item(C.in[19] + (size_t)e * DM * 2048, 2048, kb * 64, src, WGU + (size_t)e * 2048 * DM, nb * 32, DM, scr, C.lane); continue; } r -= I_GU;
            { const int e = r >> 9, q = r & 511, kb = q >> 5, nb = q & 31;
                p0_item(C.in[21] + (size_t)e * DM * DM, DM, kb * 64, nb * 32, WDN + (size_t)e * DM * DM, nb * 32, DM, scr, C.lane); }
        }
    }
}

__device__ __forceinline__ void p1_cumsum(const Ctx& C) {
    if ((int)blockIdx.x < BATCH * NH) {
        const int bh = blockIdx.x; const float* src = WSP(float, WS_LOGF) + (size_t)bh * SEQ + 8 * C.tid; float* dst = WSP(float, WS_C2) + (size_t)bh * SEQ + 8 * C.tid;
        LAS float* wtot = (LAS float*)C.lds;
        const f32x4 a = *(const f32x4*)src, b = *(const f32x4*)(src + 4);
        float v[8] = {a.x, a.y, a.z, a.w, b.x, b.y, b.z, b.w};
#pragma unroll
        for (int e = 1; e < 8; ++e) v[e] += v[e - 1];
        const float run = v[7]; float s = run;
#pragma unroll
        for (int o = 1; o < 64; o <<= 1) { const float t = __shfl_up(s, o); if (C.lane >= o) s += t; }
        if (C.lane == 63) wtot[C.wave] = s;
        __syncthreads();
        float base = 0.f;
        for (int w = 0; w < C.wave; ++w) base += wtot[w];
        const float excl = base + s - run;
        f32x4 o0 = {(excl + v[0]) * LOG2E, (excl + v[1]) * LOG2E, (excl + v[2]) * LOG2E, (excl + v[3]) * LOG2E};
        f32x4 o1 = {(excl + v[4]) * LOG2E, (excl + v[5]) * LOG2E, (excl + v[6]) * LOG2E, (excl + v[7]) * LOG2E};
        *(f32x4*)dst = o0; *(f32x4*)(dst + 4) = o1;
        __syncthreads();
    }
}
struct EpiInProj {
    static constexpr bool PERM = false, AFTER_DRAIN = false;
    bf16 *U; const float *qw, *kw;
    __device__ __forceinline__ void operator()(const pg8::f32x4 (&acc)[2][2][4][2], const pg8::Unit& u, int wr, int wc, int fr, int fq) const {
        const int pn = u.pn, row0 = u.pm * 256 + wr * 64 + fr;
        if (pn < 4 || pn >= 8) {
            bf16* base = U + (size_t)(pn >> 1) * (size_t)(8u << 20); const bool act = (pn == 2 || pn == 3);
            const int col0 = (pn & 1) * 256 + wc * 32 + 4 * fq;
#pragma unroll
            for (int ai = 0; ai < 2; ++ai)
#pragma unroll
                for (int m = 0; m < 4; ++m) { bf16* rowp = base + (size_t)(row0 + ai * 128 + m * 16) * 512 + col0;
#pragma unroll
                    for (int bj = 0; bj < 2; ++bj)
#pragma unroll
                        for (int n = 0; n < 2; ++n) { pg8::f32x4 v = acc[ai][bj][m][n];
                            if (act) { v[0] = gelu_tanh(v[0]); v[1] = gelu_tanh(v[1]); v[2] = gelu_tanh(v[2]); v[3] = gelu_tanh(v[3]); }
                            u32x2 w; w.x = cvtpk(v[0], v[1]); w.y = cvtpk(v[2], v[3]); *(u32x2*)(rowp + bj * 128 + n * 16) = w; } }
        } else {
            const bool isq = pn < 6; bf16* base = U + (size_t)(pn >> 1) * (size_t)(8u << 20); const float* wp = isq ? qw : kw; const float sc = isq ? QSCALE : 1.0f;
            const int head = (pn & 1) * 4 + wc;
            pg8::f32x4 wv[2][2];
#pragma unroll
            for (int bj = 0; bj < 2; ++bj)
#pragma unroll
                for (int n = 0; n < 2; ++n) wv[bj][n] = *(const pg8::f32x4*)(wp + 32 * bj + 16 * n + 4 * fq) * sc;
#pragma unroll
            for (int ai = 0; ai < 2; ++ai)
#pragma unroll
                for (int m = 0; m < 4; ++m) {
                    float ss = 0.f;
#pragma unroll
                    for (int bj = 0; bj < 2; ++bj)
#pragma unroll
                        for (int n = 0; n < 2; ++n) { const pg8::f32x4 v = acc[ai][bj][m][n]; ss += (v[0] * v[0] + v[1] * v[1]) + (v[2] * v[2] + v[3] * v[3]); }
                    ss += __shfl_xor(ss, 16); ss += __shfl_xor(ss, 32);
                    const float rstd = 1.0f / sqrtf(ss * (1.0f / HD) + EPS);
                    bf16* rowp = base + (size_t)(row0 + ai * 128 + m * 16) * 512 + head * 64 + 4 * fq;
#pragma unroll
                    for (int bj = 0; bj < 2; ++bj)
#pragma unroll
                        for (int n = 0; n < 2; ++n) { const pg8::f32x4 v = acc[ai][bj][m][n] * rstd * wv[bj][n];
                            u32x2 w; w.x = cvtpk(v[0], v[1]); w.y = cvtpk(v[2], v[3]); *(u32x2*)(rowp + 32 * bj + 16 * n) = w; } }
        }
    }
};

__device__ __forceinline__ void lru_pass1(const Ctx& C, int unit) {
    const int b = unit >> 6, ch = unit & 63, row0 = b * SEQ + ch * CHUNK, g = C.wave, lane = C.lane, j32 = lane & 31, hi = lane >> 5;
    const bf16* U = WSP(bf16, WS_U);
    float* HLOC = WSP(float, WS_HLOC); float* PC = WSP(float, WS_PC);
    LAS float* XC = (LAS float*)C.lds + C.wave * (64 * 68);
    {
        const int c = 64 * g + lane; const float* conv_w = C.in[3];
        const float cw0 = conv_w[c], cw1 = conv_w[512 + c], cw2 = conv_w[1024 + c], cw3 = conv_w[1536 + c], cb = C.in[4][c];
        float um3 = 0.f, um2 = 0.f, um1 = 0.f;
        if (ch > 0) { um3 = bf2f(U[(size_t)(row0 - 3) * 512 + c]); um2 = bf2f(U[(size_t)(row0 - 2) * 512 + c]); um1 = bf2f(U[(size_t)(row0 - 1) * 512 + c]); }
#pragma unroll 8
        for (int tt = 0; tt < CHUNK; ++tt) {
            const float ut = bf2f(U[(size_t)(row0 + tt) * 512 + c]);
            XC[tt * 68 + lane] = cb + cw0 * um3 + cw1 * um2 + cw2 * um1 + cw3 * ut;
            um3 = um2; um2 = um1; um1 = ut;
        }
    }
    LDS_WAIT(); asm volatile("" ::: "memory");
    bf16x8 xa[2][4];
#pragma unroll
    for (int tb = 0; tb < 2; ++tb)
#pragma unroll
        for (int ks = 0; ks < 4; ++ks) { const LAS float* p = XC + (32 * tb + j32) * 68 + 16 * ks + 8 * hi; const f32x4 lo = *(const LAS f32x4*)p, h4 = *(const LAS f32x4*)(p + 4);
            const v4u ux = {cvtpk(lo.x, lo.y), cvtpk(lo.z, lo.w), cvtpk(h4.x, h4.y), cvtpk(h4.z, h4.w)}; xa[tb][ks] = __builtin_bit_cast(bf16x8, ux); }
#pragma unroll 1
    for (int jb = 0; jb < 2; ++jb) {
        const int c = 64 * g + 32 * jb + j32;
        const float ba = C.in[6][c], bi = C.in[8][c], lam = C.in[9][c];
        const float sp8 = 8.0f * (fmaxf(-lam, 0.f) + log1pf(expf(-fabsf(lam))));
        float Cin = 0.f, Pin = 1.f;
        bf16x8 wa[4], wi[4];
#pragma unroll
        for (int ks = 0; ks < 4; ++ks) {
            const float* pa = C.in[5] + (size_t)(g * 64 + 16 * ks + 8 * hi) * 64 + 32 * jb + j32; const float* pi = C.in[7] + (size_t)(g * 64 + 16 * ks + 8 * hi) * 64 + 32 * jb + j32;
            const v4u ua = {cvtpk(pa[0], pa[64]), cvtpk(pa[128], pa[192]), cvtpk(pa[256], pa[320]), cvtpk(pa[384], pa[448])};
            const v4u ui = {cvtpk(pi[0], pi[64]), cvtpk(pi[128], pi[192]), cvtpk(pi[256], pi[320]), cvtpk(pi[384], pi[448])};
            wa[ks] = __builtin_bit_cast(bf16x8, ua); wi[ks] = __builtin_bit_cast(bf16x8, ui);
        }
#pragma unroll
        for (int tb = 0; tb < 2; ++tb) {
            f32x16 ra = {}, ri = {};
#pragma unroll
            for (int ks = 0; ks < 4; ++ks) {
                ra = __builtin_amdgcn_mfma_f32_32x32x16_bf16(xa[tb][ks], wa[ks], ra, 0, 0, 0); ri = __builtin_amdgcn_mfma_f32_32x32x16_bf16(xa[tb][ks], wi[ks], ri, 0, 0, 0); }
            float hl[16], pl[16], Ao[4], Bo[4], Ap[4], Bp[4], cin[4], pin[4];
#pragma unroll
            for (int r = 0; r < 16; ++r) {
                const float xo = XC[(32 * tb + crow(r, hi)) * 68 + 32 * jb + j32];
                const float rr = fast_sigmoid(ra[r] + ba), ig = fast_sigmoid(ri[r] + bi);
                const float a = fast_exp(-sp8 * rr);
                const float bb = sqrtf(fmaxf(1.0f - a * a, 0.f)) * ig * xo;
                if ((r & 3) == 0) { hl[r] = bb; pl[r] = a; } else { hl[r] = a * hl[r - 1] + bb; pl[r] = pl[r - 1] * a; }
            }
#pragma unroll
            for (int rg = 0; rg < 4; ++rg) { Ao[rg] = pl[4 * rg + 3]; Bo[rg] = hl[4 * rg + 3]; Ap[rg] = __shfl_xor(Ao[rg], 32); Bp[rg] = __shfl_xor(Bo[rg], 32); }
#pragma unroll
            for (int rg = 0; rg < 4; ++rg)
#pragma unroll
                for (int half = 0; half < 2; ++half) {
                    const bool own = (half == hi); const float As = own ? Ao[rg] : Ap[rg], Bs = own ? Bo[rg] : Bp[rg];
                    if (half == 0) { cin[rg] = Cin; pin[rg] = Pin; } else { cin[rg] = own ? Cin : cin[rg]; pin[rg] = own ? Pin : pin[rg]; }
                    Cin = As * Cin + Bs; Pin = Pin * As;
                }
#pragma unroll
            for (int r = 0; r < 16; ++r) { const size_t off = (size_t)(row0 + 32 * tb + crow(r, hi)) * 512 + c;
                HLOC[off] = hl[r] + pl[r] * cin[r >> 2]; PC[off] = pl[r] * pin[r >> 2]; }
        }
        if (hi == 0) { WSP(float, WS_AEND)[(size_t)(b * NCHUNK + ch) * 512 + c] = Pin; WSP(float, WS_BEND)[(size_t)(b * NCHUNK + ch) * 512 + c] = Cin; }
    }
    __syncthreads();
}

__device__ __forceinline__ s16x4 vtr(const LAS unsigned char* p) { typedef short v4i16_t __attribute__((ext_vector_type(4))); return __builtin_bit_cast(s16x4, __builtin_amdgcn_ds_read_tr16_b64_v4i16((LAS v4i16_t*)p)); }
__device__ __forceinline__ void attn_unit(const Ctx& C, int b, int h, int qb, float thr2) {
    const int tid = C.tid, lane = C.lane, wave = C.wave, r32 = lane & 31, hi = lane >> 5;
    const bf16* Qg = WSP(bf16, WS_Q); const bf16* Kg = WSP(bf16, WS_K); const bf16* Vg = WSP(bf16, WS_V); bf16* Og = WSP(bf16, WS_ATT);
    const float* c2 = WSP(float, WS_C2) + (size_t)(b * NH + h) * SEQ;
    const int q0 = qb * 256, rowbase = b * SEQ, qg = q0 + wave * 32 + r32;
    LAS unsigned char* Kl = C.lds; LAS unsigned char* Vl = C.lds + 16384; LAS float* CKl = (LAS float*)(C.lds + 32768);
    bf16x8 qf[4];
    { const bf16* qp = Qg + (size_t)(rowbase + qg) * 512 + h * 64 + 8 * hi;
#pragma unroll
      for (int ds = 0; ds < 4; ++ds) qf[ds] = *(const bf16x8*)(qp + 16 * ds); }
    const float cq = c2[qg];
    const int NTl = (q0 + 256) / 64;
    int tstart;
    { const float cq0 = c2[q0]; const bool ok = (lane >= NTl) || (cq0 - c2[(lane < NTl ? lane : 0) * 64 + 63] >= thr2);
      const unsigned long long bal = __ballot(ok); tstart = __builtin_amdgcn_readfirstlane((int)__builtin_ctzll(bal)); if (tstart >= NTl) tstart = NTl - 1; }
    const int srow = tid >> 3, sch = tid & 7;
    const bf16* kp = Kg + (size_t)(rowbase + srow) * 512 + h * 64 + sch * 8; const bf16* vp = Vg + (size_t)(rowbase + srow) * 512 + h * 64 + sch * 8;
    const int koff = srow * 128 + ((sch ^ (srow & 7)) << 4), voff = srow * 128 + (sch << 4);
    v4u kreg = *(const v4u*)(kp + (size_t)tstart * 64 * 512), vreg = *(const v4u*)(vp + (size_t)tstart * 64 * 512); float ckreg = (tid < 64) ? c2[tstart * 64 + tid] : 0.f;
    *(LAS v4u*)(Kl + koff) = kreg; *(LAS v4u*)(Vl + voff) = vreg; if (tid < 64) CKl[tid] = ckreg;
    __syncthreads();
    float mrun = -1e30f, lrun = 0.f; f32x16 o0 = {}, o1 = {};
    const int qlast = q0 + wave * 32 + 31, qfirst = q0 + wave * 32;
    const int kra = r32 * 128;
    const int i16 = lane & 15, g4 = lane >> 4;
    const int vra = (4 * hi + (i16 >> 2)) * 128 + (16 * (g4 & 1) + 4 * (i16 & 3)) * 2;
    for (int tt = tstart; tt < NTl; ++tt) {
        const int cur = (tt - tstart) & 1; const bool more = (tt + 1 < NTl);
        if (more) { kreg = *(const v4u*)(kp + (size_t)(tt + 1) * 64 * 512); vreg = *(const v4u*)(vp + (size_t)(tt + 1) * 64 * 512); if (tid < 64) ckreg = c2[(tt + 1) * 64 + tid]; }
        const int k0 = tt * 64;
        if (k0 <= qlast) {
            const LAS unsigned char* Kc = Kl + cur * 8192; const LAS unsigned char* Vc = Vl + cur * 8192; const LAS float* CKc = CKl + cur * 64;
            f32x16 p0, p1;
#pragma unroll
            for (int r = 0; r < 16; ++r) { p0[r] = cq; p1[r] = cq; }
#pragma unroll
            for (int ds = 0; ds < 4; ++ds) {
                const int chs = ((2 * ds + hi) ^ (r32 & 7)) << 4;
                const bf16x8 ka = *(const LAS bf16x8*)(Kc + kra + chs), kb = *(const LAS bf16x8*)(Kc + 4096 + kra + chs);
                p0 = __builtin_amdgcn_mfma_f32_32x32x16_bf16(ka, qf[ds], p0, 0, 0, 0);
                p1 = __builtin_amdgcn_mfma_f32_32x32x16_bf16(kb, qf[ds], p1, 0, 0, 0);
            }
#pragma unroll
            for (int g = 0; g < 4; ++g) { const f32x4 ca = *(const LAS f32x4*)(CKc + 8 * g + 4 * hi), cb = *(const LAS f32x4*)(CKc + 32 + 8 * g + 4 * hi);
                p0[4 * g] -= ca.x; p0[4 * g + 1] -= ca.y; p0[4 * g + 2] -= ca.z; p0[4 * g + 3] -= ca.w;
                p1[4 * g] -= cb.x; p1[4 * g + 1] -= cb.y; p1[4 * g + 2] -= cb.z; p1[4 * g + 3] -= cb.w; }
            if (k0 + 63 > qfirst) {
#pragma unroll
                for (int r = 0; r < 16; ++r) { const int kv = k0 + crow(r, hi); if (kv > qg) p0[r] = -INFINITY; if (kv + 32 > qg) p1[r] = -INFINITY; }
            }
            float mx = fmaxf(p0[0], p1[0]);
#pragma unroll
            for (int r = 1; r < 16; ++r) mx = fmaxf(mx, fmaxf(p0[r], p1[r]));
            { auto rr = __builtin_amdgcn_permlane32_swap(__float_as_uint(mx), __float_as_uint(mx), false, false); mx = fmaxf(__uint_as_float(rr[0]), __uint_as_float(rr[1])); }
            const float mnew = fmaxf(mrun, mx), alpha = __builtin_amdgcn_exp2f(mrun - mnew); mrun = mnew;
            float ls = 0.f;
#pragma unroll
            for (int r = 0; r < 16; ++r) { p0[r] = __builtin_amdgcn_exp2f(p0[r] - mnew); p1[r] = __builtin_amdgcn_exp2f(p1[r] - mnew); ls += p0[r] + p1[r]; }
            lrun = lrun * alpha + ls;
#pragma unroll
            for (int r = 0; r < 16; ++r) { o0[r] *= alpha; o1[r] *= alpha; }
            v4u pw[4];
            pw[0] = (v4u){cvtpk(p0[0], p0[1]), cvtpk(p0[2], p0[3]), cvtpk(p0[4], p0[5]), cvtpk(p0[6], p0[7])};
            pw[1] = (v4u){cvtpk(p0[8], p0[9]), cvtpk(p0[10], p0[11]), cvtpk(p0[12], p0[13]), cvtpk(p0[14], p0[15])};
            pw[2] = (v4u){cvtpk(p1[0], p1[1]), cvtpk(p1[2], p1[3]), cvtpk(p1[4], p1[5]), cvtpk(p1[6], p1[7])};
            pw[3] = (v4u){cvtpk(p1[8], p1[9]), cvtpk(p1[10], p1[11]), cvtpk(p1[12], p1[13]), cvtpk(p1[14], p1[15])};
#pragma unroll
            for (int ks = 0; ks < 4; ++ks) {
                const LAS unsigned char* vb = Vc + vra + ks * 16 * 128;
                const s16x4 a0 = vtr(vb), a1 = vtr(vb + 8 * 128), b0 = vtr(vb + 64), b1 = vtr(vb + 8 * 128 + 64);
                const bf16x8 va = {a0[0], a0[1], a0[2], a0[3], a1[0], a1[1], a1[2], a1[3]}, vbb = {b0[0], b0[1], b0[2], b0[3], b1[0], b1[1], b1[2], b1[3]};
                const bf16x8 pf = __builtin_bit_cast(bf16x8, pw[ks]);
                o0 = __builtin_amdgcn_mfma_f32_32x32x16_bf16(va, pf, o0, 0, 0, 0);
                o1 = __builtin_amdgcn_mfma_f32_32x32x16_bf16(vbb, pf, o1, 0, 0, 0);
            }
        }
        if (more) { const int nb = (cur ^ 1); *(LAS v4u*)(Kl + nb * 8192 + koff) = kreg; *(LAS v4u*)(Vl + nb * 8192 + voff) = vreg; if (tid < 64) CKl[nb * 64 + tid] = ckreg; }
        __syncthreads();
    }
    { auto rr = __builtin_amdgcn_permlane32_swap(__float_as_uint(lrun), __float_as_uint(lrun), false, false); lrun = __uint_as_float(rr[0]) + __uint_as_float(rr[1]); }
    const float rl = 1.0f / lrun;
    bf16* op = Og + (size_t)(rowbase + qg) * 512 + h * 64 + 4 * hi;
#pragma unroll
    for (int g = 0; g < 4; ++g) {
        u32x2 w0 = {cvtpk(o0[4 * g] * rl, o0[4 * g + 1] * rl), cvtpk(o0[4 * g + 2] * rl, o0[4 * g + 3] * rl)};
        u32x2 w1 = {cvtpk(o1[4 * g] * rl, o1[4 * g + 1] * rl), cvtpk(o1[4 * g + 2] * rl, o1[4 * g + 3] * rl)};
        *(u32x2*)(op + 8 * g) = w0; *(u32x2*)(op + 32 + 8 * g) = w1;
    }
}
__device__ __forceinline__ void attn_phase(const Ctx& C) {
    const float qm = wave_max(fabsf(C.in[11][C.lane])), km = wave_max(fabsf(C.in[12][C.lane]));
    const float smax = 8.0f * qm * km * 1.05f;
    const float thr2 = -(104.0f + 2.0f * smax) * LOG2E;
    for (int v = C.vcu; v < 256; v += C.G) {
        const int bh = v >> 3, s = v & 7;
        attn_unit(C, bh >> 3, bh & 7, 15 - s, thr2);
        attn_unit(C, bh >> 3, bh & 7, s, thr2);
    }
}

__device__ __forceinline__ void post_phase(const Ctx& C, int unit) {
    const int b = unit >> 6, ch = unit & 63;
    LAS float* Hc = (LAS float*)C.lds;
    { const float* A = WSP(float, WS_AEND) + (size_t)b * NCHUNK * 512 + C.tid; const float* B = WSP(float, WS_BEND) + (size_t)b * NCHUNK * 512 + C.tid;
      float H = 0.f;
      for (int k = 0; k < ch; ++k) H = A[k * 512] * H + B[k * 512];
      Hc[C.tid] = H; }
    __syncthreads();
    const float* HLOC = WSP(float, WS_HLOC); const float* PC = WSP(float, WS_PC); const bf16* GG = WSP(bf16, WS_GG); const bf16* ATT = WSP(bf16, WS_ATT); bf16* MIX = WSP(bf16, WS_MIX);
    const int c8 = 8 * C.lane;
    const f32x4 h0 = *(const LAS f32x4*)(Hc + c8), h1 = *(const LAS f32x4*)(Hc + c8 + 4);
    const f32x4 wr0 = *(const f32x4*)(C.in[13] + c8), wr1 = *(const f32x4*)(C.in[13] + c8 + 4), wa0 = *(const f32x4*)(C.in[14] + c8), wa1 = *(const f32x4*)(C.in[14] + c8 + 4);
    for (int i = 0; i < 8; ++i) {
        const size_t row = (size_t)b * SEQ + ch * CHUNK + C.wave * 8 + i;
        const f32x4 l0 = *(const f32x4*)(HLOC + row * 512 + c8), l1 = *(const f32x4*)(HLOC + row * 512 + c8 + 4);
        const f32x4 p0 = *(const f32x4*)(PC + row * 512 + c8), p1 = *(const f32x4*)(PC + row * 512 + c8 + 4);
        const v4u gw = *(const v4u*)(GG + row * 512 + c8), aw = *(const v4u*)(ATT + row * 512 + c8);
        f32x4 r0 = l0 + p0 * h0, r1 = l1 + p1 * h1;
        r0.x *= bflo(gw.x); r0.y *= bfhi(gw.x); r0.z *= bflo(gw.y); r0.w *= bfhi(gw.y); r1.x *= bflo(gw.z); r1.y *= bfhi(gw.z); r1.z *= bflo(gw.w); r1.w *= bfhi(gw.w);
        float ss = (r0.x * r0.x + r0.y * r0.y) + (r0.z * r0.z + r0.w * r0.w) + (r1.x * r1.x + r1.y * r1.y) + (r1.z * r1.z + r1.w * r1.w);
        f32x4 a0 = {bflo(aw.x), bfhi(aw.x), bflo(aw.y), bfhi(aw.y)}, a1 = {bflo(aw.z), bfhi(aw.z), bflo(aw.w), bfhi(aw.w)};
        float sa = (a0.x * a0.x + a0.y * a0.y) + (a0.z * a0.z + a0.w * a0.w) + (a1.x * a1.x + a1.y * a1.y) + (a1.z * a1.z + a1.w * a1.w);
        const float rs = 1.0f / sqrtf(wave_sum(ss) * (1.0f / DREC) + EPS), ra = 1.0f / sqrtf(wave_sum(sa) * (1.0f / DATT) + EPS);
        r0 = r0 * rs * wr0; r1 = r1 * rs * wr1; a0 = a0 * ra * wa0; a1 = a1 * ra * wa1;
        *(v4u*)(MIX + row * DM + c8) = (v4u){cvtpk(r0.x, r0.y), cvtpk(r0.z, r0.w), cvtpk(r1.x, r1.y), cvtpk(r1.z, r1.w)};
        *(v4u*)(MIX + row * DM + 512 + c8) = (v4u){cvtpk(a0.x, a0.y), cvtpk(a0.z, a0.w), cvtpk(a1.x, a1.y), cvtpk(a1.z, a1.w)};
    }
    __syncthreads();
}

struct EpiRes {
    static constexpr bool PERM = false, AFTER_DRAIN = false;
    const float* x; float* out;
    __device__ __forceinline__ void operator()(const pg8::f32x4 (&acc)[2][2][4][2], const pg8::Unit& u, int wr, int wc, int fr, int fq) const {
        const int row0 = u.pm * 256 + wr * 64 + fr, col0 = u.pn * 256 + wc * 32 + 4 * fq;
#pragma unroll
        for (int ai = 0; ai < 2; ++ai)
#pragma unroll
            for (int m = 0; m < 4; ++m) { const size_t off = (size_t)(row0 + ai * 128 + m * 16) * DM + col0;
#pragma unroll
                for (int bj = 0; bj < 2; ++bj)
#pragma unroll
                    for (int n = 0; n < 2; ++n) { const pg8::f32x4 xv = *(const pg8::f32x4*)(x + off + bj * 128 + n * 16); *(pg8::f32x4*)(out + off + bj * 128 + n * 16) = xv + acc[ai][bj][m][n]; } }
    }
};

__device__ __forceinline__ void router_phase(const Ctx& C) {
    LAS float* wrT = (LAS float*)C.lds;
    LAS int* lcnt = (LAS int*)(C.lds + TAB_OFF);
    LAS int* gbase = lcnt + 32;
    LAS int* te = gbase + 32;
    LAS int* tp = te + 256;
    { const float* wr = C.in[17]; const float* ln2 = C.in[16];
      for (int idx = C.tid; idx < DM * NE; idx += NWAVES * 64) { const int d = idx >> 5, e = idx & 31; wrT[e * 1028 + d] = wr[idx] * ln2[d]; }
      if (C.tid < 32) lcnt[C.tid] = 0; }
    __syncthreads();
    const float* x1 = C.out; const float* br = C.in[18];
    float* RSTD2 = WSP(float, WS_RSTD2); int* TKE = WSP(int, WS_TKE); int* TKP = WSP(int, WS_TKP); float* TKG = WSP(float, WS_TKG);
    unsigned* cnt = (unsigned*)(C.ws + WS_CTL) + CW_CNT;
    for (int unit = C.vcu; unit < M / 64; unit += C.G) {
        for (int i = 0; i < 8; ++i) {
            const int tl = C.wave * 8 + i, t = unit * 64 + tl;
            const f32x4* xr = (const f32x4*)(x1 + (size_t)t * DM) + C.lane;
            f32x4 v[4]; float ss = 0.f;
#pragma unroll
            for (int jj = 0; jj < 4; ++jj) { v[jj] = xr[64 * jj]; ss += (v[jj].x * v[jj].x + v[jj].y * v[jj].y) + (v[jj].z * v[jj].z + v[jj].w * v[jj].w); }
            const float rstd = 1.0f / sqrtf(wave_sum(ss) * (1.0f / DM) + EPS);
#pragma unroll
            for (int jj = 0; jj < 4; ++jj) v[jj] = v[jj] * rstd;
            float lg[32];
#pragma unroll
            for (int e = 0; e < 32; ++e) { float a = 0.f;
#pragma unroll
                for (int jj = 0; jj < 4; ++jj) { const f32x4 wv = *(const LAS f32x4*)(wrT + e * 1028 + 4 * C.lane + 256 * jj); a += (v[jj].x * wv.x + v[jj].y * wv.y) + (v[jj].z * wv.z + v[jj].w * wv.w); }
                lg[e] = wave_sum(a) + br[e]; }
            float tv[4]; int ti[4];
#pragma unroll
            for (int k = 0; k < 4; ++k) { float best = -INFINITY; int bi = 0;
#pragma unroll
                for (int e = 0; e < 32; ++e) { const bool gt = lg[e] > best; best = gt ? lg[e] : best; bi = gt ? e : bi; }
                tv[k] = best; ti[k] = bi;
#pragma unroll
                for (int e = 0; e < 32; ++e) lg[e] = (e == bi) ? -INFINITY : lg[e]; }
            const float e1 = fast_exp(tv[1] - tv[0]), e2 = fast_exp(tv[2] - tv[0]), e3 = fast_exp(tv[3] - tv[0]); const float inv = 1.0f / (1.0f + e1 + e2 + e3);
            if (C.lane < 4) { const int k = C.lane; const int ek = k == 0 ? ti[0] : k == 1 ? ti[1] : k == 2 ? ti[2] : ti[3]; const float gk = (k == 0 ? 1.0f : k == 1 ? e1 : k == 2 ? e2 : e3) * inv;
                const int lp = __hip_atomic_fetch_add(lcnt + ek, 1, __ATOMIC_RELAXED, __HIP_MEMORY_SCOPE_WORKGROUP);
                te[tl * 4 + k] = ek; tp[tl * 4 + k] = lp; TKG[(size_t)t * 4 + k] = gk; }
            if (C.lane == 0) RSTD2[t] = rstd;
        }
        __syncthreads();
        if (C.tid < 32) { gbase[C.tid] = (int)__hip_atomic_fetch_add(cnt + 64 * C.tid, (unsigned)lcnt[C.tid], __ATOMIC_RELAXED, __HIP_MEMORY_SCOPE_AGENT); }
        __syncthreads();
        if (C.tid < 256) { const int e = te[C.tid]; TKE[(size_t)unit * 256 + C.tid] = e; TKP[(size_t)unit * 256 + C.tid] = gbase[e] + tp[C.tid]; }
        __syncthreads();
        if (C.tid < 32) lcnt[C.tid] = 0;
        __syncthreads();
    }
}

__device__ __forceinline__ void build_tables(const Ctx& C) {
    LAS int* padstart = (LAS int*)(C.lds + TAB_OFF);
    LAS int* tile_e = padstart + 40;
    const unsigned* cnt = (const unsigned*)(C.ws + WS_CTL) + CW_CNT;
    if (C.tid == 0) { int acc = 0; for (int e = 0; e < NE; ++e) { padstart[e] = acc; const int c = (int)__hip_atomic_load(cnt + 64 * e, __ATOMIC_RELAXED, __HIP_MEMORY_SCOPE_AGENT); acc += (c + 255) & ~255; } padstart[NE] = acc; }
    __syncthreads();
    if (C.tid < MAXMT) { const int r = C.tid * 256; int e = 0;
#pragma unroll 1
        for (int k = 1; k < NE; ++k) e = (padstart[k] <= r) ? k : e;
        tile_e[C.tid] = e; }
    __syncthreads();
}

__device__ __forceinline__ void gather_phase(const Ctx& C) {
    const LAS int* padstart = (const LAS int*)(C.lds + TAB_OFF);
    const float* x1 = C.out; const float* ln2 = C.in[16];
    const float* RSTD2 = WSP(float, WS_RSTD2); const int* TKE = WSP(int, WS_TKE); const int* TKP = WSP(int, WS_TKP); const float* TKG = WSP(float, WS_TKG);
    bf16* XS = WSP(bf16, WS_XS); float* SLOTG = WSP(float, WS_SLOTG);
    f32x4 w[4];
#pragma unroll
    for (int jj = 0; jj < 4; ++jj) w[jj] = *(const f32x4*)(ln2 + 4 * C.lane + 256 * jj);
    const int gw = C.vcu * NWAVES + C.wave, NGW = C.G * NWAVES;
    for (int t = gw; t < M; t += NGW) {
        const f32x4* xr = (const f32x4*)(x1 + (size_t)t * DM) + C.lane; const float rstd = RSTD2[t];
        unsigned long long pk[4];
#pragma unroll
        for (int jj = 0; jj < 4; ++jj) { const f32x4 v = xr[64 * jj] * rstd * w[jj]; pk[jj] = (unsigned long long)cvtpk(v.x, v.y) | ((unsigned long long)cvtpk(v.z, v.w) << 32); }
#pragma unroll
        for (int k = 0; k < 4; ++k) { const int e = TKE[(size_t)t * 4 + k], slot = padstart[e] + TKP[(size_t)t * 4 + k];
            unsigned long long* o8 = (unsigned long long*)(XS + (size_t)slot * DM) + C.lane;
#pragma unroll
            for (int jj = 0; jj < 4; ++jj) o8[64 * jj] = pk[jj];
            if (C.lane == 0) SLOTG[slot] = TKG[(size_t)t * 4 + k]; }
    }
}

struct MoeOrder {
    int nM, nN, nwg, G, c; const LAS int* tile_e;
    __device__ __forceinline__ bool next(int i, pg8::Unit& u) const {
        const long L = (long)i * G + c; if (L >= nwg) return false;
        int wgid = (int)L; { const int q = nwg / 8, r = nwg % 8, xcd = wgid % 8, off = wgid / 8; wgid = (xcd < r ? xcd * (q + 1) : r * (q + 1) + (xcd - r) * q) + off; }
        const int nig = 8 * nN, gid = wgid / nig, fm = gid * 8, gsz = (nM - fm) < 8 ? (nM - fm) : 8;
        const int pm = fm + ((wgid % nig) % gsz), pnl = (wgid % nig) / gsz;
        u.pm = pm; u.pn = tile_e[pm] * nN + pnl; return true;
    }
    __device__ __forceinline__ void a_ready(const pg8::Unit&) const {}
    __device__ __forceinline__ void done(const pg8::Unit&) const {}
};
struct EpiGateUp {
    static constexpr bool PERM = false, AFTER_DRAIN = false;
    bf16* H; const float* bgu;
    __device__ __forceinline__ void operator()(const pg8::f32x4 (&acc)[2][2][4][2], const pg8::Unit& u, int wr, int wc, int fr, int fq) const {
        const int e = u.pn >> 3, pnl = u.pn & 7, row0 = u.pm * 256 + wr * 64 + fr, col0 = 128 * pnl + 32 * wc + 4 * fq;
        const float* bg = bgu + (size_t)e * 2048 + col0;
        pg8::f32x4 bgv[2], buv[2];
#pragma unroll
        for (int n = 0; n < 2; ++n) { bgv[n] = *(const pg8::f32x4*)(bg + 16 * n); buv[n] = *(const pg8::f32x4*)(bg + 1024 + 16 * n); }
#pragma unroll
        for (int ai = 0; ai < 2; ++ai)
#pragma unroll
            for (int m = 0; m < 4; ++m) { bf16* rowp = H + (size_t)(row0 + ai * 128 + m * 16) * DM + col0;
#pragma unroll
                for (int n = 0; n < 2; ++n) { const pg8::f32x4 gv = acc[ai][0][m][n] + bgv[n], uv = acc[ai][1][m][n] + buv[n]; float a[4];
#pragma unroll
                    for (int j = 0; j < 4; ++j) { const float g = fminf(gv[j], 7.0f), uu = fminf(fmaxf(uv[j], -7.0f), 7.0f); a[j] = (uu + 1.0f) * g * fast_sigmoid(1.702f * g); }
                    u32x2 w; w.x = cvtpk(a[0], a[1]); w.y = cvtpk(a[2], a[3]); *(u32x2*)(rowp + 16 * n) = w; } }
    }
};
struct EpiDown {
    static constexpr bool PERM = false, AFTER_DRAIN = false;
    bf16* Y; const float* bd; const float* slotg;
    __device__ __forceinline__ void operator()(const pg8::f32x4 (&acc)[2][2][4][2], const pg8::Unit& u, int wr, int wc, int fr, int fq) const {
        const int e = u.pn >> 2, pnl = u.pn & 3, row0 = u.pm * 256 + wr * 64 + fr, col0 = 256 * pnl + 32 * wc + 4 * fq;
        const float* bp = bd + (size_t)e * DM + col0;
        pg8::f32x4 bv[2][2];
#pragma unroll
        for (int bj = 0; bj < 2; ++bj)
#pragma unroll
            for (int n = 0; n < 2; ++n) bv[bj][n] = *(const pg8::f32x4*)(bp + 128 * bj + 16 * n);
#pragma unroll
        for (int ai = 0; ai < 2; ++ai)
#pragma unroll
            for (int m = 0; m < 4; ++m) { const int row = row0 + ai * 128 + m * 16; const float gt = slotg[row]; bf16* rowp = Y + (size_t)row * DM + col0;
#pragma unroll
                for (int bj = 0; bj < 2; ++bj)
#pragma unroll
                    for (int n = 0; n < 2; ++n) { const pg8::f32x4 v = (acc[ai][bj][m][n] + bv[bj][n]) * gt; u32x2 w; w.x = cvtpk(v[0], v[1]); w.y = cvtpk(v[2], v[3]); *(u32x2*)(rowp + 128 * bj + 16 * n) = w; } }
    }
};

__device__ __forceinline__ void combine_phase(const Ctx& C) {
    const LAS int* padstart = (const LAS int*)(C.lds + TAB_OFF);
    float* out = C.out; const int* TKE = WSP(int, WS_TKE); const int* TKP = WSP(int, WS_TKP); const bf16* YS = WSP(bf16, WS_YS);
    const int gw = C.vcu * NWAVES + C.wave, NGW = C.G * NWAVES;
    for (int t = gw; t < M; t += NGW) {
        f32x4* xr = (f32x4*)(out + (size_t)t * DM) + C.lane;
        f32x4 v[4];
#pragma unroll
        for (int jj = 0; jj < 4; ++jj) v[jj] = xr[64 * jj];
#pragma unroll
        for (int k = 0; k < 4; ++k) { const int slot = padstart[TKE[(size_t)t * 4 + k]] + TKP[(size_t)t * 4 + k];
            const u32x2* yp = (const u32x2*)(YS + (size_t)slot * DM) + C.lane;
#pragma unroll
            for (int jj = 0; jj < 4; ++jj) { const u32x2 y = yp[64 * jj]; v[jj].x += bflo(y.x); v[jj].y += bfhi(y.x); v[jj].z += bflo(y.y); v[jj].w += bfhi(y.y); } }
#pragma unroll
        for (int jj = 0; jj < 4; ++jj) xr[64 * jj] = v[jj];
    }
}

struct Args { const float* in[23]; float* out; unsigned char* ws; int ph_lo, ph_hi; };
__global__ void __launch_bounds__(NWAVES * 64, 2) fwd_kernel(Args args) {
    extern __shared__ __attribute__((aligned(16))) unsigned char lds[];
    Ctx C;
    C.lds = (LAS unsigned char*)lds;
    C.tid = threadIdx.x; C.lane = C.tid & 63; C.wave = __builtin_amdgcn_readfirstlane(C.tid >> 6);
    C.G = gridDim.x; { const int bx = blockIdx.x; C.vcu = (C.G % 8 == 0) ? (bx % 8) * (C.G / 8) + bx / 8 : bx; }
#pragma unroll
    for (int i = 0; i < 23; ++i) C.in[i] = args.in[i];
    C.out = args.out; C.ws = args.ws;
    volatile LAS unsigned* MISC = (volatile LAS unsigned*)(C.lds + MISC_OFF);
    for (int u = C.tid; u < (LDS_BYTES - LDSCTL_OFF) / 4; u += NWAVES * 64) ((LAS unsigned*)(C.lds + LDSCTL_OFF))[u] = 0u;
    __syncthreads();
    XcdBarrier bar; bar.bar = (unsigned*)(C.ws + WS_CTL) + CW_BAR; bar.x = 0; bar.st = nullptr;
    if (N_LAUNCHES != PER_PHASE) bar = xcd_barrier_post((unsigned*)(C.ws + WS_CTL) + CW_BAR, MISC + 8);
    const int lo = args.ph_lo, hi = args.ph_hi;
#ifndef PHASE_MASK
#define PHASE_MASK 0x3ff
#endif
#define IN(k) (((PHASE_MASK >> (k)) & 1) && lo <= (k) && (k) < hi)
#define BOTH(k) (IN(k) && IN((k) + 1))
#define GRID_BAR() do { if (N_LAUNCHES != PER_PHASE) xcd_barrier(bar); } while (0)

    if (IN(0)) { p0_prologue(C); if (BOTH(0)) GRID_BAR(); }

    if (IN(1)) {
#ifndef NO_CUMSUM
        p1_cumsum(C);
#endif
        pg8::Gemm g{WSP(bf16, WS_XN), WSP(bf16, WS_WIN), M, NPROJ, DM}; pg8::StaticOrder S; S.init(M, NPROJ, C.G, (int)blockIdx.x);
        EpiInProj E{WSP(bf16, WS_U), C.in[11], C.in[12]};
        pg8::gemm_phase<EpiInProj, pg8::StaticOrder, true, true>(C.lds, g, S, E);
        if (BOTH(1)) GRID_BAR();
    }

    if (IN(2)) {
#ifndef NO_LRU
        for (int u = C.vcu; u < BATCH * NCHUNK; u += C.G) lru_pass1(C, u);
#endif
#ifndef NO_ATTN
        attn_phase(C);
#endif
        if (BOTH(2)) GRID_BAR();
    }

    if (IN(3)) {
        for (int u = C.vcu; u < BATCH * NCHUNK; u += C.G) post_phase(C, u);
        if (BOTH(3)) GRID_BAR();
    }

    if (IN(4)) {
        pg8::Gemm g{WSP(bf16, WS_MIX), WSP(bf16, WS_WOUT), M, DM, DM}; pg8::StaticOrder S; S.init(M, DM, C.G, (int)blockIdx.x);
        EpiRes E{C.in[0], C.out};
        pg8::gemm_phase<EpiRes, pg8::StaticOrder, true, true>(C.lds, g, S, E);
        if (BOTH(4)) GRID_BAR();
    }

    if (IN(5)) { router_phase(C); if (BOTH(5)) GRID_BAR(); }

    if (IN(6)) { build_tables(C); gather_phase(C); if (BOTH(6)) GRID_BAR(); }

    if (IN(7)) {
        if (!IN(6)) build_tables(C);
        const LAS int* padstart = (const LAS int*)(C.lds + TAB_OFF); const int MT = padstart[NE] >> 8;
        pg8::Gemm g{WSP(bf16, WS_XS), WSP(bf16, WS_WGU), MAXSLOT, NE * 2048, DM};
        MoeOrder S{MT, 8, MT * 8, C.G, (int)blockIdx.x, padstart + 40};
        EpiGateUp E{WSP(bf16, WS_HB), C.in[20]};
        pg8::gemm_phase<EpiGateUp, MoeOrder, true, true>(C.lds, g, S, E);
        if (BOTH(7)) GRID_BAR();
    }

    if (IN(8)) {
        if (!IN(6) && !IN(7)) build_tables(C);
        const LAS int* padstart = (const LAS int*)(C.lds + TAB_OFF); const int MT = padstart[NE] >> 8;
        pg8::Gemm g{WSP(bf16, WS_HB), WSP(bf16, WS_WDN), MAXSLOT, NE * DM, DM};
        MoeOrder S{MT, 4, MT * 4, C.G, (int)blockIdx.x, padstart + 40};
        EpiDown E{WSP(bf16, WS_YS), C.in[22], WSP(float, WS_SLOTG)};
        pg8::gemm_phase<EpiDown, MoeOrder, true, true>(C.lds, g, S, E);
        if (BOTH(8)) GRID_BAR();
    }

    if (IN(9)) {
        if (!IN(6) && !IN(7) && !IN(8)) build_tables(C);
        combine_phase(C);
    }
#undef IN
#undef BOTH
#undef GRID_BAR
}

extern "C" void kernel_launch(void* const* d_in, const int* in_sizes, int n_in, void* d_out, int out_size, void* d_ws, size_t ws_size, hipStream_t stream) {
    static int grid = 0;
    if (grid == 0) {
        if (n_in != 23 || in_sizes[0] != M * DM || out_size != M * DM || ws_size < WS_END) { fprintf(stderr, "kernel_launch: unexpected shapes (n_in %d, in0 %d, out %d, ws %zu); nothing launched\n", n_in, n_in > 0 ? in_sizes[0] : -1, out_size, ws_size); grid = -1; return; }
        int dev = 0, cus = 0, per_cu = 0;
        if (hipGetDevice(&dev) != hipSuccess || hipDeviceGetAttribute(&cus, hipDeviceAttributeMultiprocessorCount, dev) != hipSuccess) { fprintf(stderr, "kernel_launch: device query failed\n"); grid = -1; return; }
        if (hipFuncSetAttribute((const void*)fwd_kernel, hipFuncAttributeMaxDynamicSharedMemorySize, LDS_BYTES) != hipSuccess) { fprintf(stderr, "kernel_launch: hipFuncSetAttribute failed\n"); grid = -1; return; }
        if (hipOccupancyMaxActiveBlocksPerMultiprocessor(&per_cu, (const void*)fwd_kernel, NWAVES * 64, LDS_BYTES) != hipSuccess || per_cu < 1) { fprintf(stderr, "kernel_launch: occupancy query reports %d workgroups per CU; nothing launched\n", per_cu); (void)hipGetLastError(); grid = -1; return; }
        grid = cus;
    }
    if (grid < 0) return;
    if (hipMemsetAsync((char*)d_ws + WS_CTL, 0, CTL_ZERO_BYTES, stream) != hipSuccess) { fprintf(stderr, "kernel_launch: hipMemsetAsync failed\n"); return; }
    Args a{};
    for (int i = 0; i < 23; ++i) a.in[i] = (const float*)d_in[i];
    a.out = (float*)d_out; a.ws = (unsigned char*)d_ws;
    for (int li = 0; li < N_LAUNCHES; ++li) {
        a.ph_lo = (N_LAUNCHES == PER_PHASE) ? li : 0; a.ph_hi = (N_LAUNCHES == PER_PHASE) ? li + 1 : PER_PHASE;
        hipLaunchKernelGGL(fwd_kernel, dim3(grid), dim3(NWAVES * 64), LDS_BYTES, stream, a);
        const hipError_t le = hipPeekAtLastError();
        if (le != hipSuccess) { fprintf(stderr, "kernel_launch: launch %d failed: %s\n", li, hipGetErrorName(le)); break; }
    }
}
```

```cpp
#include <hip/hip_runtime.h>
#include <cstdio>
#include <cstdint>
namespace pg8 {
#define PG8_LAS __attribute__((address_space(3)))
typedef unsigned short bf16_t;
typedef short bf16x8 __attribute__((ext_vector_type(8)));
typedef float f32x4 __attribute__((ext_vector_type(4)));
typedef unsigned u32x4 __attribute__((ext_vector_type(4)));
constexpr int BM = 256, BK = 64, HALF = 128, HTB = HALF * BK * 2  , STAGE_BYTES = 8 * HTB, NXCD = 8, WGM = 8;

__host__ __device__ __forceinline__ int lds_byte(int r, int c) { const int st = (r >> 4) * 2 + (c >> 5), rr = r & 15, cc = c & 31, ob = rr * 64 + cc * 2; return st * 1024 + (ob ^ (((ob >> 9) & 1) << 5)); }
__host__ __device__ __forceinline__ void stage_rc(int b, int& R, int& C) { const int st = b / 1024, sb = b % 1024, swz = sb ^ (((sb >> 9) & 1) << 5); R = (st >> 1) * 16 + swz / 64; C = (st & 1) * 32 + (swz % 64) / 2; }
__host__ __device__ __forceinline__ int perm32(int rho) { const int n = rho >> 4, i = rho & 15; return 8 * (i >> 2) + 4 * n + (i & 3); }

struct Unit { int pm, pn; };
struct Gemm { const bf16_t* A; const bf16_t* Bt; int M, N, K; };

struct StaticOrder {
    int nM, nN, nwg, G, c;
    __host__ __device__ void init(int M, int N, int G_, int c_) { nM = M / BM; nN = N / BM; nwg = nM * nN; G = G_; c = c_; }
    __host__ __device__ bool next(int i, Unit& u) const {
        const long L = (long)i * G + c; if (L >= nwg) return false;
        int wgid = (int)L; { const int q = nwg / NXCD, r = nwg % NXCD, xcd = wgid % NXCD, off = wgid / NXCD; wgid = (xcd < r ? xcd * (q + 1) : r * (q + 1) + (xcd - r) * q) + off; }
        const int nig = WGM * nN, gid = wgid / nig, fm = gid * WGM, gsz = (nM - fm) < WGM ? (nM - fm) : WGM;
        u.pm = fm + ((wgid % nig) % gsz); u.pn = (wgid % nig) / gsz; return true;
    }
    __device__ __forceinline__ void a_ready(const Unit&) const {}
    __device__ __forceinline__ void done(const Unit&) const {}
};

__device__ __forceinline__ unsigned cvt_pk_bf16(float lo, float hi) { unsigned r; asm volatile("v_cvt_pk_bf16_f32 %0, %1, %2" : "=v"(r) : "v"(lo), "v"(hi)); return r; }
typedef int i32x4 __attribute__((ext_vector_type(4)));
typedef int i32x8 __attribute__((ext_vector_type(8)));
__device__ __forceinline__ i32x8 pg8_cat(bf16x8 a, bf16x8 b) { const i32x4 x = __builtin_bit_cast(i32x4, a), y = __builtin_bit_cast(i32x4, b); return __builtin_shufflevector(x, y, 0, 1, 2, 3, 4, 5, 6, 7); }
__device__ __forceinline__ void pg8_mfma_f8(f32x4& c, const i32x8& a, const i32x8& b) { asm volatile("v_mfma_f32_16x16x128_f8f6f4 %0, %1, %2, %0" : "+v"(c) : "v"(a), "v"(b)); }
template <class Epi, class Sched, bool ALIGN_EPI = false, bool SP2 = false, bool FP8 = false, bool GATHER = false>
__device__ __forceinline__ void gemm_phase(PG8_LAS unsigned char* lds, const Gemm g, const Sched& S, const Epi& E) {
    const int tid = threadIdx.x, wid = __builtin_amdgcn_readfirstlane(tid >> 6), lane = tid & 63, wr = wid >> 2, wc = wid & 3, fr = lane & 15, fq = lane >> 4;
    const int K = g.K, nt = K / BK;
    unsigned voffA[2], voffB[2], rcR[2], rcC[2];
#pragma unroll
    for (int i = 0; i < 2; ++i) { int R, C; stage_rc(tid * 16 + i * 8192, R, C); const int Rb = Epi::PERM ? ((R & ~31) + perm32(R & 31)) : R;
        voffA[i] = (unsigned)(R * K + C) * 2u; voffB[i] = (unsigned)(Rb * K + C) * 2u; rcR[i] = (unsigned)R; rcC[i] = (unsigned)C * 2u; }
    const size_t kstep = (size_t)(BK * 2);
    const size_t hstep = (size_t)HALF * K * 2;
    const size_t tstep = 2 * hstep;
    unsigned gA[2][2], gN[2][2];
#define PG8_GOFF(dst, uidx) do { _Pragma("unroll") for (int h_ = 0; h_ < 2; ++h_) _Pragma("unroll") for (int i_ = 0; i_ < 2; ++i_) { \
        if constexpr (GATHER) dst[h_][i_] = (unsigned)S.arow((uidx), h_ * HALF + (int)rcR[i_]) * (unsigned)(K * 2) + rcC[i_]; else dst[h_][i_] = voffA[i_] + (unsigned)(h_ * hstep); } } while (0)
    const unsigned ldsw = (unsigned)wid * 1024u;
    const int aoff = lds_byte(wr * 64 + fr, fq * 8), boff = lds_byte(wc * 32 + fr, fq * 8);
#define PG8_SA(b, h) (((b) * 2 + (h)) * HTB)
#define PG8_SB(b, h) ((4 + (b) * 2 + (h)) * HTB)
#define PG8_STAGE(bufoff, gbase, voff) do { _Pragma("unroll") for (int _i = 0; _i < 2; ++_i) \
        __builtin_amdgcn_global_load_lds((const unsigned*)((const char*)(gbase) + (voff)[_i]), (PG8_LAS unsigned*)(lds + (bufoff) + ldsw + _i * 8192), 16, 0, 0); } while (0)
#define PG8_LDA(dst, b, h) do { if constexpr (FP8) { _Pragma("unroll") for (int m = 0; m < 4; ++m) dst##8[m] = pg8_cat(*(const PG8_LAS bf16x8*)(lds + PG8_SA(b, h) + aoff + m * 2048), *(const PG8_LAS bf16x8*)(lds + PG8_SA(b, h) + aoff + m * 2048 + 1024)); } else { \
        _Pragma("unroll") for (int m = 0; m < 4; ++m) _Pragma("unroll") for (int k = 0; k < 2; ++k) dst[m][k] = *(const PG8_LAS bf16x8*)(lds + PG8_SA(b, h) + aoff + m * 2048 + k * 1024); } } while (0)
#define PG8_LDB(dst, b, h) do { if constexpr (FP8) { _Pragma("unroll") for (int n = 0; n < 2; ++n) dst##8[n] = pg8_cat(*(const PG8_LAS bf16x8*)(lds + PG8_SB(b, h) + boff + n * 2048), *(const PG8_LAS bf16x8*)(lds + PG8_SB(b, h) + boff + n * 2048 + 1024)); } else { \
        _Pragma("unroll") for (int n = 0; n < 2; ++n) _Pragma("unroll") for (int k = 0; k < 2; ++k) dst[n][k] = *(const PG8_LAS bf16x8*)(lds + PG8_SB(b, h) + boff + n * 2048 + k * 1024); } } while (0)
#define PG8_MMA(ai, bj, At, Bt) do { __builtin_amdgcn_s_setprio(1); if constexpr (FP8) { _Pragma("unroll") for (int m = 0; m < 4; ++m) _Pragma("unroll") for (int n = 0; n < 2; ++n) \
        pg8_mfma_f8(acc[ai][bj][m][n], Bt##8[n], At##8[m]); } else { \
        _Pragma("unroll") for (int m = 0; m < 4; ++m) _Pragma("unroll") for (int n = 0; n < 2; ++n) _Pragma("unroll") for (int k = 0; k < 2; ++k) \
        acc[ai][bj][m][n] = __builtin_amdgcn_mfma_f32_16x16x32_bf16(Bt[n][k], At[m][k], acc[ai][bj][m][n], 0, 0, 0); } __builtin_amdgcn_s_setprio(0); } while (0)
#define PG8_WAIT_V(n) asm volatile("s_waitcnt vmcnt(" #n ")" ::: "memory")
#define PG8_WAIT_L(n) asm volatile("s_waitcnt lgkmcnt(" #n ")" ::: "memory")
#define PG8_BAR __builtin_amdgcn_s_barrier()
#define PG8_SCHED __builtin_amdgcn_sched_barrier(0)
    Unit cur, nxt; int ui = 0;
    if (!S.next(0, cur)) return;
    f32x4 acc[2][2][4][2];
#pragma unroll
    for (int a = 0; a < 2; ++a)
#pragma unroll
        for (int b = 0; b < 2; ++b)
#pragma unroll
            for (int m = 0; m < 4; ++m)
#pragma unroll
                for (int n = 0; n < 2; ++n) acc[a][b][m][n] = (f32x4){0.f, 0.f, 0.f, 0.f};
    bf16x8 At[4][2], B0[2][2], B1[2][2]; i32x8 At8[4], B08[2], B18[2];
    const char* cA = GATHER ? (const char*)g.A : (const char*)g.A + (size_t)cur.pm * tstep; const char* cB = (const char*)g.Bt + (size_t)(GATHER ? (cur.pn & 0xffff) : cur.pn) * tstep;
    PG8_GOFF(gA, 0); PG8_GOFF(gN, 0);
    S.a_ready(cur);
    if constexpr (SP2) {
        PG8_STAGE(PG8_SB(0, 0), cB, voffB); PG8_STAGE(PG8_SB(0, 1), cB + hstep, voffB); PG8_STAGE(PG8_SA(0, 0), cA, gA[0]); PG8_STAGE(PG8_SA(0, 1), cA, gA[1]);
        if (wr == 1) PG8_BAR;
        PG8_WAIT_V(2); PG8_BAR;
        PG8_STAGE(PG8_SB(1, 0), cB + kstep, voffB); PG8_STAGE(PG8_SA(1, 0), cA + kstep, gA[0]); PG8_STAGE(PG8_SB(1, 1), cB + hstep + kstep, voffB);
        PG8_WAIT_V(6); PG8_BAR;
    } else {
        PG8_STAGE(PG8_SB(0, 0), cB, voffB); PG8_STAGE(PG8_SA(0, 0), cA, gA[0]); PG8_STAGE(PG8_SB(0, 1), cB + hstep, voffB); PG8_STAGE(PG8_SA(0, 1), cA, gA[1]);
        if (wr == 1) PG8_BAR;
        PG8_WAIT_V(4); PG8_BAR;
        PG8_STAGE(PG8_SB(1, 0), cB + kstep, voffB); PG8_STAGE(PG8_SA(1, 0), cA + kstep, gA[0]); PG8_STAGE(PG8_SB(1, 1), cB + hstep + kstep, voffB);
        PG8_WAIT_V(6); PG8_BAR;
    }
    for (;;) {
        const bool has_next = S.next(ui + 1, nxt);
        const char* nA = (has_next && !GATHER) ? (const char*)g.A + (size_t)nxt.pm * tstep : cA; const char* nB = has_next ? (const char*)g.Bt + (size_t)(GATHER ? (nxt.pn & 0xffff) : nxt.pn) * tstep : cB;
        if constexpr (GATHER) { if (has_next) PG8_GOFF(gN, ui + 1); }
        _Pragma("nounroll") for (int t = 0; t < nt; t += 2) {
            const bool last = (t == nt - 2);
            const char* a1 = cA + (size_t)(t + 1) * kstep;
            const char* a2 = last ? nA : cA + (size_t)(t + 2) * kstep; const char* b2 = last ? nB : cB + (size_t)(t + 2) * kstep;
            const char* a3 = a2 + kstep; const char* b3 = b2 + kstep;
            unsigned g2[2][2];
#pragma unroll
            for (int h_ = 0; h_ < 2; ++h_)
#pragma unroll
                for (int i_ = 0; i_ < 2; ++i_) g2[h_][i_] = (GATHER && last) ? gN[h_][i_] : gA[h_][i_];
            if (last && has_next) S.a_ready(nxt);
            if constexpr (SP2) {
            PG8_LDB(B0, 0, 0); PG8_LDB(B1, 0, 1); PG8_SCHED; PG8_LDA(At, 0, 0); PG8_STAGE(PG8_SA(1, 1), a1, gA[1]);
            PG8_WAIT_V(8); PG8_WAIT_L(0); PG8_BAR; PG8_MMA(0, 0, At, B0); PG8_MMA(0, 1, At, B1); PG8_BAR; PG8_SCHED;
            PG8_LDA(At, 0, 1); PG8_STAGE(PG8_SB(0, 0), b2, voffB); PG8_STAGE(PG8_SB(0, 1), b2 + hstep, voffB); PG8_STAGE(PG8_SA(0, 0), a2, g2[0]);
            PG8_WAIT_V(8); PG8_WAIT_L(0); PG8_BAR; PG8_MMA(1, 0, At, B0); PG8_MMA(1, 1, At, B1); PG8_BAR; PG8_SCHED;
            PG8_LDB(B0, 1, 0); PG8_LDB(B1, 1, 1); PG8_SCHED; PG8_LDA(At, 1, 0); PG8_STAGE(PG8_SA(0, 1), a2, g2[1]);
            PG8_WAIT_V(8); PG8_WAIT_L(0); PG8_BAR; PG8_MMA(0, 0, At, B0); PG8_MMA(0, 1, At, B1); PG8_BAR; PG8_SCHED;
            PG8_LDA(At, 1, 1); PG8_STAGE(PG8_SB(1, 0), b3, voffB); PG8_STAGE(PG8_SB(1, 1), b3 + hstep, voffB); PG8_STAGE(PG8_SA(1, 0), a3, g2[0]);
            PG8_WAIT_V(8); PG8_WAIT_L(0); PG8_BAR; PG8_MMA(1, 0, At, B0); PG8_MMA(1, 1, At, B1); PG8_BAR; PG8_SCHED;
            } else {
            PG8_LDB(B0, 0, 0); PG8_SCHED; PG8_LDA(At, 0, 0); PG8_STAGE(PG8_SA(1, 1), a1, gA[1]);
            PG8_WAIT_L(8); PG8_BAR; PG8_WAIT_L(0); PG8_MMA(0, 0, At, B0); PG8_BAR; PG8_SCHED;
            PG8_LDB(B1, 0, 1); PG8_STAGE(PG8_SB(0, 0), b2, voffB);
            PG8_BAR; PG8_WAIT_L(0); PG8_MMA(0, 1, At, B1); PG8_BAR;
            PG8_LDA(At, 0, 1); PG8_STAGE(PG8_SA(0, 0), a2, g2[0]);
            PG8_BAR; PG8_WAIT_L(0); PG8_MMA(1, 0, At, B0); PG8_BAR; PG8_SCHED;
            PG8_STAGE(PG8_SB(0, 1), b2 + hstep, voffB);
            PG8_WAIT_V(6); PG8_BAR; PG8_MMA(1, 1, At, B1); PG8_BAR;
            PG8_LDB(B0, 1, 0); PG8_SCHED; PG8_LDA(At, 1, 0); PG8_STAGE(PG8_SA(0, 1), a2, g2[1]);
            PG8_WAIT_L(8); PG8_BAR; PG8_WAIT_L(0); PG8_MMA(0, 0, At, B0); PG8_BAR; PG8_SCHED;
            PG8_LDB(B1, 1, 1); PG8_STAGE(PG8_SB(1, 0), b3, voffB);
            PG8_BAR; PG8_WAIT_L(0); PG8_MMA(0, 1, At, B1); PG8_BAR;
            PG8_LDA(At, 1, 1); PG8_STAGE(PG8_SA(1, 0), a3, g2[0]);
            PG8_BAR; PG8_WAIT_L(0); PG8_MMA(1, 0, At, B0); PG8_BAR; PG8_SCHED;
            PG8_STAGE(PG8_SB(1, 1), b3 + hstep, voffB);
            PG8_WAIT_V(6); PG8_BAR; PG8_MMA(1, 1, At, B1); PG8_BAR;
            }
        }
        if constexpr (ALIGN_EPI) { if (wr == 0) PG8_BAR; }
        if constexpr (FP8) { asm volatile("s_nop 15\n\ts_nop 7" ::: "memory"); __builtin_amdgcn_sched_barrier(0); }
        if constexpr (!Epi::AFTER_DRAIN) { E(acc, cur, wr, wc, fr, fq); S.done(cur); }
        if (!has_next) break;
#pragma unroll
        for (int a = 0; a < 2; ++a)
#pragma unroll
            for (int b = 0; b < 2; ++b)
#pragma unroll
                for (int m = 0; m < 4; ++m)
#pragma unroll
                    for (int n = 0; n < 2; ++n) acc[a][b][m][n] = (f32x4){0.f, 0.f, 0.f, 0.f};
        cur = nxt; cA = nA; cB = nB; ++ui;
        if constexpr (GATHER) {
#pragma unroll
            for (int h_ = 0; h_ < 2; ++h_)
#pragma unroll
                for (int i_ = 0; i_ < 2; ++i_) gA[h_][i_] = gN[h_][i_]; }
        if constexpr (ALIGN_EPI) { if (wr == 1) PG8_BAR; }
    }
    PG8_WAIT_V(0);
    if constexpr (!ALIGN_EPI) { if (wr == 0) PG8_BAR; }
    PG8_BAR;
    if constexpr (Epi::AFTER_DRAIN) { E.fused(acc, cur, wr, wc, fr, fq, lds, wid, lane); S.done(cur); }
#undef PG8_SA
#undef PG8_GOFF
#undef PG8_SB
#undef PG8_STAGE
#undef PG8_LDA
#undef PG8_LDB
#undef PG8_MMA
#undef PG8_WAIT_V
#undef PG8_WAIT_L
#undef PG8_BAR
#undef PG8_SCHED
}
}
#define GAS __attribute__((address_space(1)))
#define LAS __attribute__((address_space(3)))
typedef unsigned short bf16;
typedef unsigned v4u __attribute__((ext_vector_type(4)));
typedef float f32x4 __attribute__((ext_vector_type(4)));
typedef short bf16x8 __attribute__((ext_vector_type(8)));
typedef GAS unsigned gu32;
typedef GAS unsigned long long gu64;
#define RLX_AGENT __ATOMIC_RELAXED, __HIP_MEMORY_SCOPE_AGENT
#define LDS_WAIT() asm volatile("s_waitcnt lgkmcnt(0)" ::: "memory")
#define VM_WAIT() asm volatile("s_waitcnt vmcnt(0)" ::: "memory")
__device__ __forceinline__ unsigned long long rt() { return __builtin_amdgcn_s_memrealtime(); }
__device__ __forceinline__ unsigned f2bf(float f) { unsigned u = __builtin_bit_cast(unsigned, f); return (u + 0x7fffu + ((u >> 16) & 1u)) >> 16; }
__device__ __forceinline__ unsigned pk2(float lo, float hi) { return f2bf(lo) | (f2bf(hi) << 16); }

#define XB_TMO      128
#define XB_XCNT(j)  (256  + 64 * (j))
#define XB_XSUB(j)  (1280 + 64 * (j))
#define XB_XGEN(j)  (2304 + 64 * (j))
#define XB_TOP      3328
#define XB_TOPGEN   3392
#define XCD_BAR_WORDS 3456
#define XB_SPIN_CAP (1u << 18)

__device__ __forceinline__ unsigned xb_ld(unsigned* p)              { return __hip_atomic_load(p, __ATOMIC_RELAXED, __HIP_MEMORY_SCOPE_AGENT); }
__device__ __forceinline__ unsigned xb_add(unsigned* p, unsigned v) { return __hip_atomic_fetch_add(p, v, __ATOMIC_RELAXED, __HIP_MEMORY_SCOPE_AGENT); }
__device__ __forceinline__ unsigned xb_xcc_id() { return (unsigned)__builtin_amdgcn_s_getreg((3 << 11) | 20) & 0xFu; }
#define XB_SPIN(cond, bar) do { unsigned _sp = 0; while (cond) { __builtin_amdgcn_s_sleep(1); \
    if ((++_sp & 255u) == 0u) { if (xb_ld(&(bar)[XB_TMO])) break; if (_sp > XB_SPIN_CAP) { atomicAdd(&(bar)[XB_TMO], 1u); break; } } } } while (0)

struct XcdBarrier {
    unsigned* bar; unsigned x;
    volatile LAS unsigned* st;
};

__device__ __forceinline__ XcdBarrier xcd_barrier_post(unsigned* bar, volatile LAS unsigned* st) {
    XcdBarrier b; b.bar = bar; b.x = xb_xcc_id(); b.st = st;
    if (threadIdx.x == 0) (void)xb_add(&bar[XB_XCNT(b.x)], 1u);
    return b;
}
__device__ __forceinline__ void xcd_barrier_complete(unsigned* bar, unsigned x, unsigned& nloc, unsigned& nx) {
    const unsigned G = gridDim.x * gridDim.y * gridDim.z;
    unsigned sum, cnt, mine, sp = 0u;
    for (;;) {
        sum = 0u; cnt = 0u; mine = 0u;
#pragma unroll
        for (unsigned j = 0; j < 16; ++j) { const unsigned c = xb_ld(&bar[XB_XCNT(j)]); sum += c; cnt += (c > 0u) ? 1u : 0u; mine = (j == x) ? c : mine; }
        if (sum == G) break;
        __builtin_amdgcn_s_sleep(1);
        if ((++sp & 255u) == 0u) { if (xb_ld(&bar[XB_TMO])) break; if (sp > XB_SPIN_CAP) { atomicAdd(&bar[XB_TMO], 1u); break; } }
    }
    nloc = mine > 0u ? mine : 1u; nx = cnt > 0u ? cnt : 1u;
}

__device__ __forceinline__ void xcd_barrier(const XcdBarrier& b) {
    asm volatile("s_waitcnt vmcnt(0)" ::: "memory");
    __syncthreads();
    if (threadIdx.x == 0) {
        unsigned* bar = b.bar;
        __builtin_amdgcn_s_waitcnt(0);
        unsigned nloc = b.st[0], nx = b.st[1];
        if (nloc == 0u) { xcd_barrier_complete(bar, b.x, nloc, nx); b.st[0] = nloc; b.st[1] = nx; }
        const unsigned old = xb_add(&bar[XB_XSUB(b.x)], 1u);
        const unsigned gen = old / nloc;
        if (old + 1u == (gen + 1u) * nloc) {
            __builtin_amdgcn_fence(__ATOMIC_RELEASE, "agent");
            asm volatile("s_waitcnt vmcnt(0)" ::: "memory");
            const unsigned og = xb_add(&bar[XB_TOP], 1u);
            const unsigned tg = og / nx;
            if (og + 1u == (tg + 1u) * nx) xb_add(&bar[XB_TOPGEN], 1u);
            else XB_SPIN(xb_ld(&bar[XB_TOPGEN]) == tg, bar);
            __builtin_amdgcn_fence(__ATOMIC_ACQUIRE, "agent");
            xb_add(&bar[XB_XGEN(b.x)], 1u);
            asm volatile("s_waitcnt vmcnt(0)" ::: "memory");
        } else {
            XB_SPIN(xb_ld(&bar[XB_XGEN(b.x)]) == gen, bar);
            __builtin_amdgcn_fence(__ATOMIC_ACQUIRE, "agent");
            asm volatile("s_waitcnt vmcnt(0)" ::: "memory");
        }
    }
    __syncthreads();
}


constexpr int NWAVES = 8;
#ifndef MK_N_LAUNCHES
#define MK_N_LAUNCHES 1
#endif
constexpr int PER_PHASE = 10;
constexpr int N_LAUNCHES = MK_N_LAUNCHES;

constexpr int BATCH = 4, SEQ = 4096, DM = 1024, M = BATCH * SEQ;
constexpr int DREC = 512, DATT = 512, NH = 8, HD = 64;
constexpr int NPROJ = 2560, LDW_IN = 2568;
constexpr int NE = 32, TOPK = 4;
constexpr int MAXSLOT = M * TOPK + NE * 256, MAXMT = MAXSLOT / 256;
constexpr int CHUNK = 64, NCHUNK = SEQ / CHUNK;
constexpr float EPS = 1e-6f;
constexpr float LOG2E = 1.4426950408889634f;
constexpr float QSCALE = 0.125f * LOG2E;

constexpr size_t MiB = 1u << 20;
constexpr size_t WS_CTL = 0, CTL_ZERO_BYTES = 1 * MiB;
constexpr size_t WS_WIN = 2 * MiB, WS_WOUT = 8 * MiB;
constexpr size_t WS_LOGF = 10 * MiB, WS_C2 = WS_LOGF + 512 * 1024, WS_AEND = 11 * MiB, WS_BEND = WS_AEND + 512 * 1024;
constexpr size_t WS_RSTD2 = 12 * MiB, WS_TKE = WS_RSTD2 + 256 * 1024, WS_TKP = WS_TKE + 256 * 1024, WS_TKG = WS_TKP + 256 * 1024, WS_SLOTG = 13 * MiB;
constexpr size_t WS_WGU = 16 * MiB, WS_WDN = 144 * MiB, WS_XN = 208 * MiB;
constexpr size_t WS_U = 240 * MiB, WS_GG = 256 * MiB, WS_Q = 272 * MiB, WS_K = 288 * MiB, WS_V = 304 * MiB, WS_ATT = 320 * MiB;
constexpr size_t WS_HLOC = 336 * MiB, WS_PC = 368 * MiB, WS_MIX = 400 * MiB, WS_XS = 576 * MiB, WS_HB = 648 * MiB, WS_END = 738 * MiB;
constexpr size_t WS_ATT1 = 720 * MiB, WS_L0 = 736 * MiB, WS_L1 = 737 * MiB;
constexpr size_t WS_XB = 208 * MiB;
constexpr size_t WS_LIST = 576 * MiB, WS_LISTG = 578 * MiB;
constexpr size_t WS_X1B = 240 * MiB;
constexpr size_t WS_YS = 432 * MiB;
constexpr int CW_TMO = 0, CW_BAR = 4096, CW_CNT = 16384;

constexpr int LDS_BYTES = 163840, LDSCTL_OFF = 155648;
constexpr int MISC_OFF = LDSCTL_OFF;
constexpr int TAB_OFF = LDSCTL_OFF + 256;


typedef float f32x16 __attribute__((ext_vector_type(16)));
typedef float f32x2 __attribute__((ext_vector_type(2)));
typedef unsigned u32x2 __attribute__((ext_vector_type(2)));
typedef short s16x4 __attribute__((ext_vector_type(4)));
typedef __bf16 bf16x2_t __attribute__((ext_vector_type(2)));
__device__ __forceinline__ unsigned cvtpk(float lo, float hi) { f32x2 v = {lo, hi}; bf16x2_t b = __builtin_convertvector(v, bf16x2_t); return __builtin_bit_cast(unsigned, b); }
__device__ __forceinline__ float bflo(unsigned w) { return __uint_as_float(w << 16); }
__device__ __forceinline__ float bfhi(unsigned w) { return __uint_as_float(w & 0xffff0000u); }
__device__ __forceinline__ float bf2f(bf16 h) { return __uint_as_float((unsigned)h << 16); }
__device__ __forceinline__ float wave_sum(float v) {
#pragma unroll
    for (int o = 1; o < 64; o <<= 1) v += __shfl_xor(v, o);
    return v;
}
__device__ __forceinline__ float wave_max(float v) {
#pragma unroll
    for (int o = 1; o < 64; o <<= 1) v = fmaxf(v, __shfl_xor(v, o));
    return v;
}
__device__ __forceinline__ float fast_exp(float x) { return __builtin_amdgcn_exp2f(x * LOG2E); }
__device__ __forceinline__ float fast_sigmoid(float x) { return __builtin_amdgcn_rcpf(1.0f + fast_exp(-x)); }
__device__ __forceinline__ float gelu_tanh(float x) {
    const float y = 0.7978845608028654f * (x + 0.044715f * x * x * x);
    const float t = 1.0f - 2.0f * __builtin_amdgcn_rcpf(1.0f + fast_exp(2.0f * y));
    return 0.5f * x * (1.0f + t);
}
__device__ __forceinline__ f32x4 gelu_tanh4(f32x4 x) {
    const f32x4 t = (x * x) * 0.044715f + 1.0f;
    f32x4 e = (x * (-1.5957691216f * LOG2E)) * t;
#pragma unroll
    for (int j = 0; j < 4; ++j) e[j] = __builtin_amdgcn_exp2f(e[j]);
    f32x4 d = e + 1.0f;
#pragma unroll
    for (int j = 0; j < 4; ++j) d[j] = __builtin_amdgcn_rcpf(d[j]);
    return x * d;
}
__device__ __forceinline__ int crow(int r, int hi) { return (r & 3) + 8 * (r >> 2) + 4 * hi; }

struct Ctx {
    LAS unsigned char* lds;
    int tid, lane, wave, vcu, G;
    const float* in[23];
    float* out;
    unsigned char* ws;
};
#define WSP(T, off) ((T*)(C.ws + (off)))

struct P0It { const float* src; unsigned char* dst; int ldw; int fp8; };
__device__ __forceinline__ int win_src_col(int n_dst) {
    const int pn = n_dst >> 8, c = n_dst & 255;
    if (pn < 4 || pn >= 8) return n_dst;
    const int base = 1024 + (pn - 4) * 256;
    return base + ((c >> 5) & 3) * 64 + (c >> 7) * 32 + (c & 31);
}
constexpr int P0_I_IN = 16 * 80, P0_I_OUT = 16 * 32, P0_NITEMS = P0_I_IN + P0_I_OUT;
__device__ __forceinline__ P0It p0_decode(const Ctx& C, int it) {
    P0It r; int q = it;
    if (q < P0_I_IN) { const int kb = q / 80, nb = q % 80;
        r.src = C.in[2] + (size_t)(kb * 64) * LDW_IN + win_src_col(nb * 32); r.ldw = LDW_IN; r.fp8 = 0;
        r.dst = C.ws + WS_WIN + ((size_t)(nb * 32) * DM + kb * 64) * 2; return r; } q -= P0_I_IN;
    { const int kb = q >> 5, nb = q & 31;
        r.src = C.in[15] + (size_t)(kb * 64) * DM + nb * 32; r.ldw = DM; r.fp8 = 0;
        r.dst = C.ws + WS_WOUT + ((size_t)(nb * 32) * DM + kb * 64) * 2; return r; }
}
__device__ __forceinline__ void p0_load(const P0It& I, f32x4 (&v)[8], int lane) {
#pragma unroll
    for (int i = 0; i < 8; ++i) v[i] = *(const f32x4*)(I.src + (size_t)(i * 8 + (lane >> 3)) * I.ldw + (lane & 7) * 4);
}
__device__ __forceinline__ unsigned pk_fp8x4(float a, float b, float c, float d) { int w = __builtin_amdgcn_cvt_pk_fp8_f32(a, b, 0, false); w = __builtin_amdgcn_cvt_pk_fp8_f32(c, d, w, true); return (unsigned)w; }
__device__ __forceinline__ void p0_store(const P0It& I, const f32x4 (&v)[8], LAS float* scr, int lane) {
#pragma unroll
    for (int i = 0; i < 8; ++i) { LAS float* s = scr + (i * 8 + (lane >> 3)) * 33 + (lane & 7) * 4; s[0] = v[i].x; s[1] = v[i].y; s[2] = v[i].z; s[3] = v[i].w; }
    LDS_WAIT(); asm volatile("" ::: "memory");
    const int n = lane & 31;
    if (I.fp8) {
#pragma unroll
        for (int jj = 0; jj < 2; ++jj) { const int kc = (lane >> 5) + 2 * jj; const LAS float* s = scr + (16 * kc) * 33 + n;
            v4u o; o.x = pk_fp8x4(s[0] * 32.f, s[33] * 32.f, s[66] * 32.f, s[99] * 32.f); o.y = pk_fp8x4(s[132] * 32.f, s[165] * 32.f, s[198] * 32.f, s[231] * 32.f);
            o.z = pk_fp8x4(s[264] * 32.f, s[297] * 32.f, s[330] * 32.f, s[363] * 32.f); o.w = pk_fp8x4(s[396] * 32.f, s[429] * 32.f, s[462] * 32.f, s[495] * 32.f);
            *(v4u*)(I.dst + (size_t)n * 1024 + 16 * kc) = o; }
    } else {
#pragma unroll
        for (int jj = 0; jj < 4; ++jj) { const int kc = (lane >> 5) + 2 * jj; const LAS float* s = scr + (8 * kc) * 33 + n;
            v4u o; o.x = cvtpk(s[0], s[33]); o.y = cvtpk(s[66], s[99]); o.z = cvtpk(s[132], s[165]); o.w = cvtpk(s[198], s[231]);
            *(v4u*)(I.dst + (size_t)n * 2048 + 16 * kc) = o; }
    }
    LDS_WAIT(); asm volatile("" ::: "memory");
}
__device__ __forceinline__ void p0_prologue(const Ctx& C) {
    LAS float* scr = (LAS float*)(C.lds + C.wave * 8448);
    LAS float* wfT = (LAS float*)(C.lds + 69632);
    const float* w_in = C.in[2];
    { float wv_[16], lv_[16];
#pragma unroll
      for (int i = 0; i < 16; ++i) { const int idx = C.tid + i * NWAVES * 64, d = idx >> 3; wv_[i] = w_in[(size_t)d * LDW_IN + NPROJ + (idx & 7)]; lv_[i] = C.in[1][d]; }
#pragma unroll
      for (int i = 0; i < 16; ++i) { const int idx = C.tid + i * NWAVES * 64; wfT[(idx & 7) * 1024 + (idx >> 3)] = wv_[i] * lv_[i]; } }
    __syncthreads();
    const int gw = C.vcu * NWAVES + C.wave, NGW = C.G * NWAVES;
    {
        const float* x = C.in[0]; const float* ln1 = C.in[1]; const float* bfg = C.in[10];
        bf16* XN = WSP(bf16, WS_XN); float* LOGF = WSP(float, WS_LOGF);
        f32x4 w[4], v[4], vn[4];
#pragma unroll
        for (int jj = 0; jj < 4; ++jj) { w[jj] = *(const f32x4*)(ln1 + 4 * C.lane + 256 * jj); v[jj] = ((const f32x4*)(x + (size_t)gw * DM) + C.lane)[64 * jj]; vn[jj] = v[jj]; }
        for (int m = gw; m < M; m += NGW) {
            { const int mn = (m + NGW < M) ? m + NGW : m;
#pragma unroll
              for (int jj = 0; jj < 4; ++jj) vn[jj] = ((const f32x4*)(x + (size_t)mn * DM) + C.lane)[64 * jj]; }
            float ss = 0.f, f[8];
#pragma unroll
            for (int jj = 0; jj < 4; ++jj) ss += (v[jj].x * v[jj].x + v[jj].y * v[jj].y) + (v[jj].z * v[jj].z + v[jj].w * v[jj].w);
#pragma unroll
            for (int j = 0; j < 8; ++j) { float a = 0.f;
#pragma unroll
                for (int jj = 0; jj < 4; ++jj) { const f32x4 wv = *(const LAS f32x4*)(wfT + j * 1024 + 4 * C.lane + 256 * jj); a += (v[jj].x * wv.x + v[jj].y * wv.y) + (v[jj].z * wv.z + v[jj].w * wv.w); }
                f[j] = a; }
#pragma unroll
            for (int o = 1; o < 64; o <<= 1) {
                ss += __shfl_xor(ss, o);
#pragma unroll
                for (int j = 0; j < 8; ++j) f[j] += __shfl_xor(f[j], o); }
            const float rstd = 1.0f / sqrtf(ss * (1.0f / DM) + EPS);
#pragma unroll
            for (int j = 0; j < 8; ++j) f[j] *= rstd;
#pragma unroll
            for (int jj = 0; jj < 4; ++jj) v[jj] = v[jj] * rstd * w[jj];
            unsigned long long* o8 = (unsigned long long*)(XN + (size_t)m * DM) + C.lane;
#pragma unroll
            for (int jj = 0; jj < 4; ++jj) o8[64 * jj] = (unsigned long long)cvtpk(v[jj].x, v[jj].y) | ((unsigned long long)cvtpk(v[jj].z, v[jj].w) << 32);
            float z = f[0];
#pragma unroll
            for (int j = 1; j < 8; ++j) z = (C.lane == j) ? f[j] : z;
            if (C.lane < 8) { z += bfg[C.lane]; const float ls = fminf(z, 0.f) - log1pf(expf(-fabsf(z))); const int b = m >> 12, t = m & 4095; LOGF[(size_t)(b * NH + C.lane) * SEQ + t] = ls; }
#pragma unroll
            for (int jj = 0; jj < 4; ++jj) v[jj] = vn[jj];
        }
    }
    {
        f32x4 va[8], vb[8];
        int it = gw < P0_NITEMS ? gw : P0_NITEMS - 1;
        P0It ia = p0_decode(C, it), ib = ia;
        p0_load(ia, va, C.lane);
        for (; it < P0_NITEMS && gw < P0_NITEMS; it += 2 * NGW) {
            { const int n1 = (it + NGW < P0_NITEMS) ? it + NGW : it; ib = p0_decode(C, n1); p0_load(ib, vb, C.lane); }
            p0_store(ia, va, scr, C.lane);
            if (it + NGW >= P0_NITEMS) break;
            { const int n2 = (it + 2 * NGW < P0_NITEMS) ? it + 2 * NGW : it; ia = p0_decode(C, n2); p0_load(ia, va, C.lane); }
            p0_store(ib, vb, scr, C.lane);
        }
    }
}

__device__ __forceinline__ void p1_cumsum(const Ctx& C) {
    if ((int)blockIdx.x >= (int)gridDim.x - BATCH * NH) {
        const int bh = (int)blockIdx.x - ((int)gridDim.x - BATCH * NH); const float* src = WSP(float, WS_LOGF) + (size_t)bh * SEQ + 8 * C.tid; float* dst = WSP(float, WS_C2) + (size_t)bh * SEQ + 8 * C.tid;
        LAS float* wtot = (LAS float*)C.lds;
        const f32x4 a = *(const f32x4*)src, b = *(const f32x4*)(src + 4);
        float v[8] = {a.x, a.y, a.z, a.w, b.x, b.y, b.z, b.w};
#pragma unroll
        for (int e = 1; e < 8; ++e) v[e] += v[e - 1];
        const float run = v[7]; float s = run;
#pragma unroll
        for (int o = 1; o < 64; o <<= 1) { const float t = __shfl_up(s, o); if (C.lane >= o) s += t; }
        if (C.lane == 63) wtot[C.wave] = s;
        __syncthreads();
        float base = 0.f;
        for (int w = 0; w < C.wave; ++w) base += wtot[w];
        const float excl = base + s - run;
        f32x4 o0 = {(excl + v[0]) * LOG2E, (excl + v[1]) * LOG2E, (excl + v[2]) * LOG2E, (excl + v[3]) * LOG2E};
        f32x4 o1 = {(excl + v[4]) * LOG2E, (excl + v[5]) * LOG2E, (excl + v[6]) * LOG2E, (excl + v[7]) * LOG2E};
        *(f32x4*)dst = o0; *(f32x4*)(dst + 4) = o1;
        __syncthreads();
    }
}
struct EpiInProj {
    static constexpr bool PERM = true, AFTER_DRAIN = false;
    bf16 *U; const float *qw, *kw;
    __device__ __forceinline__ void operator()(const pg8::f32x4 (&acc)[2][2][4][2], const pg8::Unit& u, int wr, int wc, int fr, int fq) const {
        const int pn = u.pn, row0 = u.pm * 256 + wr * 64 + fr;
        if (pn < 4 || pn >= 8) {
            bf16* base = U + (size_t)(pn >> 1) * (size_t)(8u << 20); const bool act = (pn == 2 || pn == 3);
            const int col0 = (pn & 1) * 256 + wc * 32 + 8 * fq;
#pragma unroll
            for (int ai = 0; ai < 2; ++ai)
#pragma unroll
                for (int m = 0; m < 4; ++m) { bf16* rowp = base + (size_t)(row0 + ai * 128 + m * 16) * 512 + col0;
#pragma unroll
                    for (int bj = 0; bj < 2; ++bj) { pg8::f32x4 v0 = acc[ai][bj][m][0], v1 = acc[ai][bj][m][1];
                        if (act) { v0 = gelu_tanh4(v0); v1 = gelu_tanh4(v1); }
                        *(v4u*)(rowp + bj * 128) = (v4u){cvtpk(v0[0], v0[1]), cvtpk(v0[2], v0[3]), cvtpk(v1[0], v1[1]), cvtpk(v1[2], v1[3])}; } }
        } else {
            const bool isq = pn < 6; bf16* base = U + (size_t)(pn >> 1) * (size_t)(8u << 20); const float* wp = isq ? qw : kw; const float sc = isq ? QSCALE : 1.0f;
            const int head = (pn & 1) * 4 + wc;
            pg8::f32x4 wv[2][2];
#pragma unroll
            for (int bj = 0; bj < 2; ++bj)
#pragma unroll
                for (int n = 0; n < 2; ++n) wv[bj][n] = *(const pg8::f32x4*)(wp + 32 * bj + 8 * fq + 4 * n) * sc;
#pragma unroll
            for (int ai = 0; ai < 2; ++ai)
#pragma unroll
                for (int m = 0; m < 4; ++m) {
                    float ss = 0.f;
#pragma unroll
                    for (int bj = 0; bj < 2; ++bj)
#pragma unroll
                        for (int n = 0; n < 2; ++n) { const pg8::f32x4 v = acc[ai][bj][m][n]; ss += (v[0] * v[0] + v[1] * v[1]) + (v[2] * v[2] + v[3] * v[3]); }
                    ss += __shfl_xor(ss, 16); ss += __shfl_xor(ss, 32);
                    const float rstd = 1.0f / sqrtf(ss * (1.0f / HD) + EPS);
                    bf16* rowp = base + (size_t)(row0 + ai * 128 + m * 16) * 512 + head * 64 + 8 * fq;
#pragma unroll
                    for (int bj = 0; bj < 2; ++bj) { const pg8::f32x4 v0 = acc[ai][bj][m][0] * rstd * wv[bj][0], v1 = acc[ai][bj][m][1] * rstd * wv[bj][1];
                        *(v4u*)(rowp + 32 * bj) = (v4u){cvtpk(v0[0], v0[1]), cvtpk(v0[2], v0[3]), cvtpk(v1[0], v1[1]), cvtpk(v1[2], v1[3])}; } }
        }
    }
};

__device__ __forceinline__ void lru_pass1(const Ctx& C, int unit) {
    const int b = unit >> 6, ch = unit & 63, row0 = b * SEQ + ch * CHUNK, g = C.wave, lane = C.lane, j32 = lane & 31, hi = lane >> 5;
    const bf16* U = WSP(bf16, WS_U);
    unsigned* HP = WSP(unsigned, WS_HLOC);
    LAS float* XC = (LAS float*)C.lds + C.wave * (64 * 68);
    {
        const int c = 64 * g + lane; const float* conv_w = C.in[3];
        const float cw0 = conv_w[c], cw1 = conv_w[512 + c], cw2 = conv_w[1024 + c], cw3 = conv_w[1536 + c], cb = C.in[4][c];
        float um3 = 0.f, um2 = 0.f, um1 = 0.f;
        if (ch > 0) { um3 = bf2f(U[(size_t)(row0 - 3) * 512 + c]); um2 = bf2f(U[(size_t)(row0 - 2) * 512 + c]); um1 = bf2f(U[(size_t)(row0 - 1) * 512 + c]); }
#pragma unroll 1
        for (int t0_ = 0; t0_ < CHUNK; t0_ += 32) {
            float ut[32];
#pragma unroll
            for (int tt = 0; tt < 32; ++tt) ut[tt] = bf2f(U[(size_t)(row0 + t0_ + tt) * 512 + c]);
#pragma unroll
            for (int tt = 0; tt < 32; ++tt) {
                XC[(t0_ + tt) * 68 + lane] = cb + cw0 * um3 + cw1 * um2 + cw2 * um1 + cw3 * ut[tt];
                um3 = um2; um2 = um1; um1 = ut[tt];
            }
        }
    }
    LDS_WAIT(); asm volatile("" ::: "memory");
    bf16x8 xa[2][4];
#pragma unroll
    for (int tb = 0; tb < 2; ++tb)
#pragma unroll
        for (int ks = 0; ks < 4; ++ks) { const LAS float* p = XC + (32 * tb + j32) * 68 + 16 * ks + 8 * hi; const f32x4 lo = *(const LAS f32x4*)p, h4 = *(const LAS f32x4*)(p + 4);
            const v4u ux = {cvtpk(lo.x, lo.y), cvtpk(lo.z, lo.w), cvtpk(h4.x, h4.y), cvtpk(h4.z, h4.w)}; xa[tb][ks] = __builtin_bit_cast(bf16x8, ux); }
#pragma unroll 1
    for (int jb = 0; jb < 2; ++jb) {
        const int c = 64 * g + 32 * jb + j32;
        const float ba = C.in[6][c], bi = C.in[8][c], lam = C.in[9][c];
        const float sp8 = 8.0f * (fmaxf(-lam, 0.f) + log1pf(expf(-fabsf(lam))));
        float Cin = 0.f, Pin = 1.f;
        bf16x8 wa[4], wi[4];
#pragma unroll
        for (int ks = 0; ks < 4; ++ks) {
            const float* pa = C.in[5] + (size_t)(g * 64 + 16 * ks + 8 * hi) * 64 + 32 * jb + j32; const float* pi = C.in[7] + (size_t)(g * 64 + 16 * ks + 8 * hi) * 64 + 32 * jb + j32;
            const v4u ua = {cvtpk(pa[0], pa[64]), cvtpk(pa[128], pa[192]), cvtpk(pa[256], pa[320]), cvtpk(pa[384], pa[448])};
            const v4u ui = {cvtpk(pi[0], pi[64]), cvtpk(pi[128], pi[192]), cvtpk(pi[256], pi[320]), cvtpk(pi[384], pi[448])};
            wa[ks] = __builtin_bit_cast(bf16x8, ua); wi[ks] = __builtin_bit_cast(bf16x8, ui);
        }
#pragma unroll
        for (int tb = 0; tb < 2; ++tb) {
            f32x16 ra = {}, ri = {};
#pragma unroll
            for (int ks = 0; ks < 4; ++ks) {
                ra = __builtin_amdgcn_mfma_f32_32x32x16_bf16(xa[tb][ks], wa[ks], ra, 0, 0, 0); ri = __builtin_amdgcn_mfma_f32_32x32x16_bf16(xa[tb][ks], wi[ks], ri, 0, 0, 0); }
            float hl[16], pl[16], Ao[4], Bo[4], Ap[4], Bp[4], cin[4], pin[4];
#pragma unroll
            for (int r = 0; r < 16; ++r) {
                const float xo = XC[(32 * tb + crow(r, hi)) * 68 + 32 * jb + j32];
                const float rr = fast_sigmoid(ra[r] + ba), ig = fast_sigmoid(ri[r] + bi);
                const float a = fast_exp(-sp8 * rr);
                const float bb = sqrtf(fmaxf(1.0f - a * a, 0.f)) * ig * xo;
                if ((r & 3) == 0) { hl[r] = bb; pl[r] = a; } else { hl[r] = a * hl[r - 1] + bb; pl[r] = pl[r - 1] * a; }
            }
#pragma unroll
            for (int rg = 0; rg < 4; ++rg) { Ao[rg] = pl[4 * rg + 3]; Bo[rg] = hl[4 * rg + 3]; Ap[rg] = __shfl_xor(Ao[rg], 32); Bp[rg] = __shfl_xor(Bo[rg], 32); }
#pragma unroll
            for (int rg = 0; rg < 4; ++rg)
#pragma unroll
                for (int half = 0; half < 2; ++half) {
                    const bool own = (half == hi); const float As = own ? Ao[rg] : Ap[rg], Bs = own ? Bo[rg] : Bp[rg];
                    if (half == 0) { cin[rg] = Cin; pin[rg] = Pin; } else { cin[rg] = own ? Cin : cin[rg]; pin[rg] = own ? Pin : pin[rg]; }
                    Cin = As * Cin + Bs; Pin = Pin * As;
                }
#pragma unroll
            for (int r = 0; r < 16; ++r) { const size_t off = (size_t)(row0 + 32 * tb + crow(r, hi)) * 512 + c;
                HP[off] = cvtpk(hl[r] + pl[r] * cin[r >> 2], pl[r] * pin[r >> 2]); }
        }
        if (hi == 0) { WSP(float, WS_AEND)[(size_t)(b * NCHUNK + ch) * 512 + c] = Pin; WSP(float, WS_BEND)[(size_t)(b * NCHUNK + ch) * 512 + c] = Cin; }
    }
    __syncthreads();
}

__device__ __forceinline__ s16x4 vtr(const LAS unsigned char* p) { typedef short v4i16_t __attribute__((ext_vector_type(4))); return __builtin_bit_cast(s16x4, __builtin_amdgcn_ds_read_tr16_b64_v4i16((LAS v4i16_t*)p)); }
constexpr int ATT_SLOT = 18432;
constexpr int ATT_RING = 4 * ATT_SLOT, CV_SCR_OFF = ATT_RING, P2_LIST_OFF = CV_SCR_OFF + 8 * 8448, P2_MISC_OFF = P2_LIST_OFF + 4096;
constexpr int CV_COST = 4;
constexpr int CW_QUEUE = 20480;
constexpr int NCV_ALL = 4 * (512 + 256), NCV_P1 = 3 * 128, NCV_P7 = 256, NCV = NCV_ALL - NCV_P1 - NCV_P7, CW_DEFER = 28672;
__device__ __forceinline__ void glds16(const void* gsrc, unsigned lds_dst) { unsigned keep;
    asm volatile("s_mov_b32 %0, m0\n\ts_mov_b32 m0, %2\n\ts_nop 0\n\tglobal_load_lds_dwordx4 %1, off\n\ts_mov_b32 m0, %0" : "=&s"(keep) : "v"(gsrc), "s"(lds_dst) : "memory"); }
__device__ __forceinline__ void glds4(const void* gsrc, unsigned lds_dst) { unsigned keep;
    asm volatile("s_mov_b32 %0, m0\n\ts_mov_b32 m0, %2\n\ts_nop 0\n\tglobal_load_lds_dword %1, off\n\ts_mov_b32 m0, %0" : "=&s"(keep) : "v"(gsrc), "s"(lds_dst) : "memory"); }
__device__ __forceinline__ void attn_dma(const bf16* ksrc, const bf16* vsrc, const float* csrc, LAS unsigned char* lds, int slot, int wave) {
    const unsigned base = (unsigned)(uintptr_t)lds + (unsigned)(slot * ATT_SLOT);
    glds16(ksrc, (unsigned)__builtin_amdgcn_readfirstlane((int)(base + wave * 1024)));
    glds16(vsrc, (unsigned)__builtin_amdgcn_readfirstlane((int)(base + 8192 + wave * 1024)));
    glds4(csrc, (unsigned)__builtin_amdgcn_readfirstlane((int)(base + 16384 + wave * 256)));
}
__device__ __forceinline__ void attn_item(const Ctx& C, unsigned item, float sref) {
    const int lane = C.lane, wave = C.wave, r32 = lane & 31, hi = lane >> 5;
    const int u = item & 511, part = (item >> 9) & 1, split = (item >> 10) & 1, t0 = (item >> 11) & 127, t1 = (item >> 18) & 127;
    const int b = u >> 7, h = (u >> 4) & 7, qb = u & 15;
    const bf16* Qg = WSP(bf16, WS_Q); const bf16* Kg = WSP(bf16, WS_K); const bf16* Vg = WSP(bf16, WS_V);
    const float* c2 = WSP(float, WS_C2) + (size_t)(b * NH + h) * SEQ;
    const int q0 = qb * 256, rowbase = b * SEQ, qg = q0 + wave * 32 + r32;
    bf16x8 qf[4];
    { const bf16* qp = Qg + (size_t)(rowbase + qg) * 512 + h * 64 + 8 * hi;
#pragma unroll
      for (int ds = 0; ds < 4; ++ds) qf[ds] = *(const bf16x8*)(qp + 16 * ds); }
    const float cinit = c2[qg] - sref;
    const bf16* ksrc = Kg + (size_t)(rowbase + 8 * wave + (lane >> 3)) * 512 + h * 64 + (((lane & 7) ^ (lane >> 3)) << 3);
    const bf16* vsrc = Vg + (size_t)(rowbase + 8 * wave + (lane >> 3)) * 512 + h * 64 + ((lane & 7) << 3);
    const float* csrc = c2 + lane;
    asm volatile("" :: "v"(cinit), "v"(qf[0]), "v"(qf[1]), "v"(qf[2]), "v"(qf[3]));
    asm volatile("s_waitcnt vmcnt(0)" ::: "memory");
#pragma unroll
    for (int i = 0; i < 2; ++i) { const int tl = (t0 + i < t1) ? t0 + i : t1 - 1; attn_dma(ksrc + (size_t)tl * 64 * 512, vsrc + (size_t)tl * 64 * 512, csrc + tl * 64, C.lds, i, wave); }
    float lrun = 0.f; f32x16 o0 = {}, o1 = {};
    const int qfirst = q0 + wave * 32;
    const int kra = r32 * 128;
    const int i16 = lane & 15, g4 = lane >> 4;
    const int vra = (4 * hi + (i16 >> 2)) * 128 + (16 * (g4 & 1) + 4 * (i16 & 3)) * 2;
    f32x16 pa0, pa1;
#define ATT_WAIT_ISSUE(tt_) { \
        asm volatile("s_waitcnt vmcnt(3)" ::: "memory");                     \
        __builtin_amdgcn_s_barrier();                                        \
        asm volatile("" ::: "memory"); \
        { const int tl = ((tt_) + 2 < t1) ? (tt_) + 2 : t1 - 1; attn_dma(ksrc + (size_t)tl * 64 * 512, vsrc + (size_t)tl * 64 * 512, csrc + tl * 64, C.lds, ((tt_) - t0 + 2) & 3, wave); } }
#define ATT_QK(slot_, c0_, c1_) { \
        const LAS unsigned char* Kc = C.lds + (slot_) * ATT_SLOT; const LAS float* CKc = (const LAS float*)(Kc + 16384 + wave * 256); \
        _Pragma("unroll") for (int r = 0; r < 16; ++r) { c0_[r] = cinit; c1_[r] = cinit; } \
        _Pragma("unroll") for (int ds = 0; ds < 4; ++ds) { const int chs = ((2 * ds + hi) ^ (r32 & 7)) << 4; \
            const bf16x8 ka = *(const LAS bf16x8*)(Kc + kra + chs), kb = *(const LAS bf16x8*)(Kc + 4096 + kra + chs); \
            c0_ = __builtin_amdgcn_mfma_f32_32x32x16_bf16(ka, qf[ds], c0_, 0, 0, 0); c1_ = __builtin_amdgcn_mfma_f32_32x32x16_bf16(kb, qf[ds], c1_, 0, 0, 0); } \
        _Pragma("unroll") for (int g = 0; g < 4; ++g) { const f32x4 ca = *(const LAS f32x4*)(CKc + 8 * g + 4 * hi), cb = *(const LAS f32x4*)(CKc + 32 + 8 * g + 4 * hi); \
            c0_[4 * g] -= ca.x; c0_[4 * g + 1] -= ca.y; c0_[4 * g + 2] -= ca.z; c0_[4 * g + 3] -= ca.w; c1_[4 * g] -= cb.x; c1_[4 * g + 1] -= cb.y; c1_[4 * g + 2] -= cb.z; c1_[4 * g + 3] -= cb.w; } }
#define ATT_MASK(tt_, c0_, c1_) { const int k0 = (tt_) * 64; if (k0 + 63 > qfirst) { asm volatile("; diagonal tile: mask" ::: "memory");     \
        _Pragma("unroll") for (int r = 0; r < 16; ++r) { const int kv = k0 + crow(r, hi); if (kv > qg) c0_[r] = -INFINITY; if (kv + 32 > qg) c1_[r] = -INFINITY; } } }
#define ATT_SMPV(slot_, p0_, p1_) { \
        const LAS unsigned char* Vc = C.lds + (slot_) * ATT_SLOT + 8192; float ls = 0.f; \
        _Pragma("unroll") for (int r = 0; r < 16; ++r) { p0_[r] = __builtin_amdgcn_exp2f(p0_[r]); p1_[r] = __builtin_amdgcn_exp2f(p1_[r]); ls += p0_[r] + p1_[r]; } \
        lrun += ls; \
        v4u pw[4]; \
        pw[0] = (v4u){cvtpk(p0_[0], p0_[1]), cvtpk(p0_[2], p0_[3]), cvtpk(p0_[4], p0_[5]), cvtpk(p0_[6], p0_[7])}; \
        pw[1] = (v4u){cvtpk(p0_[8], p0_[9]), cvtpk(p0_[10], p0_[11]), cvtpk(p0_[12], p0_[13]), cvtpk(p0_[14], p0_[15])}; \
        pw[2] = (v4u){cvtpk(p1_[0], p1_[1]), cvtpk(p1_[2], p1_[3]), cvtpk(p1_[4], p1_[5]), cvtpk(p1_[6], p1_[7])}; \
        pw[3] = (v4u){cvtpk(p1_[8], p1_[9]), cvtpk(p1_[10], p1_[11]), cvtpk(p1_[12], p1_[13]), cvtpk(p1_[14], p1_[15])}; \
        _Pragma("unroll") for (int ks = 0; ks < 4; ++ks) { const LAS unsigned char* vb = Vc + vra + ks * 16 * 128; \
            const s16x4 a0 = vtr(vb), a1 = vtr(vb + 8 * 128), b0 = vtr(vb + 64), b1 = vtr(vb + 8 * 128 + 64); \
            const bf16x8 va = {a0[0], a0[1], a0[2], a0[3], a1[0], a1[1], a1[2], a1[3]}, vbb = {b0[0], b0[1], b0[2], b0[3], b1[0], b1[1], b1[2], b1[3]}; \
            const bf16x8 pf = __builtin_bit_cast(bf16x8, pw[ks]); \
            o0 = __builtin_amdgcn_mfma_f32_32x32x16_bf16(va, pf, o0, 0, 0, 0); o1 = __builtin_amdgcn_mfma_f32_32x32x16_bf16(vbb, pf, o1, 0, 0, 0); } }
    ATT_WAIT_ISSUE(t0);
    ATT_QK(0, pa0, pa1);
    ATT_MASK(t0, pa0, pa1);
    for (int tt = t0 + 1; tt < t1; ++tt) {
        const int slot = (tt - t0) & 3, pslot = (tt - t0 - 1) & 3;
        ATT_WAIT_ISSUE(tt);
        f32x16 c0, c1;
        ATT_QK(slot, c0, c1);
        ATT_SMPV(pslot, pa0, pa1);
        ATT_MASK(tt, c0, c1);
        pa0 = c0; pa1 = c1;
    }
    { const int pslot = (t1 - 1 - t0) & 3; ATT_SMPV(pslot, pa0, pa1); }
#undef ATT_WAIT_ISSUE
#undef ATT_QK
#undef ATT_MASK
#undef ATT_SMPV
    { auto rr = __builtin_amdgcn_permlane32_swap(__float_as_uint(lrun), __float_as_uint(lrun), false, false); lrun = __uint_as_float(rr[0]) + __uint_as_float(rr[1]); }
    const float rl = lrun > 0.f ? 1.0f / lrun : 0.f;
    bf16* Og = (bf16*)(C.ws + (part ? WS_ATT1 : WS_ATT));
    float* Lg = (float*)(C.ws + (part ? WS_L1 : WS_L0));
    bf16* op = Og + (size_t)(rowbase + qg) * 512 + h * 64 + 4 * hi;
#pragma unroll
    for (int g = 0; g < 4; ++g) {
        u32x2 w0 = {cvtpk(o0[4 * g] * rl, o0[4 * g + 1] * rl), cvtpk(o0[4 * g + 2] * rl, o0[4 * g + 3] * rl)};
        u32x2 w1 = {cvtpk(o1[4 * g] * rl, o1[4 * g + 1] * rl), cvtpk(o1[4 * g + 2] * rl, o1[4 * g + 3] * rl)};
        *(u32x2*)(op + 8 * g) = w0; *(u32x2*)(op + 32 + 8 * g) = w1;
    }
    if (hi == 0) { Lg[(size_t)(rowbase + qg) * NH + h] = lrun; if (!split) WSP(float, WS_L1)[(size_t)(rowbase + qg) * NH + h] = 0.f; }
    asm volatile("s_waitcnt vmcnt(0) lgkmcnt(0)" ::: "memory");
    __builtin_amdgcn_s_barrier();
    asm volatile("" ::: "memory");
}
__device__ __forceinline__ P0It cv_decode(const Ctx& C, int j, int s) {
    P0It r; r.fp8 = 1;
    const int w = s & 7, i = s >> 3, kk = i & 1, t = i >> 1;
    if (j < 512) { const int e = j >> 4, kb = 2 * ((j >> 1) & 7) + kk, nb = (j & 1) * 32 + w + 8 * t, pn = nb >> 3, c0 = (nb & 7) * 32;
        const int src = (c0 < 128) ? 128 * pn + c0 : 1024 + 128 * pn + (c0 - 128);
        r.src = C.in[19] + (size_t)e * DM * 2048 + (size_t)(kb * 64) * 2048 + src; r.ldw = 2048;
        r.dst = C.ws + WS_WGU + ((size_t)e * 2048 + nb * 32) * 1024 + kb * 64; }
    else { const int jj = j - 512, e = jj >> 3, kb = 2 * (jj & 7) + kk, nb = w + 8 * t;
        r.src = C.in[21] + (size_t)e * DM * DM + (size_t)(kb * 64) * DM + nb * 32; r.ldw = DM;
        r.dst = C.ws + WS_WDN + ((size_t)e * DM + nb * 32) * 1024 + kb * 64; }
    return r;
}
#define CV_DECODE cv_decode
#define CV_LOAD p0_load
#define CV_STORE p0_store
__device__ __forceinline__ void conv_item(const Ctx& C, int jq) {
    const int j = jq >> 2, t = jq & 3;
    LAS float* scr = (LAS float*)(C.lds + CV_SCR_OFF + C.wave * 8448);
    f32x4 v[2][8]; P0It it[2];
    it[0] = CV_DECODE(C, j, C.wave + 8 * (2 * t)); CV_LOAD(it[0], v[0], C.lane);
    it[1] = CV_DECODE(C, j, C.wave + 8 * (2 * t + 1)); CV_LOAD(it[1], v[1], C.lane);
    CV_STORE(it[0], v[0], scr, C.lane);
    CV_STORE(it[1], v[1], scr, C.lane);
}
__device__ __forceinline__ void conv_items3(const Ctx& C, int jq0) {
    LAS float* scr = (LAS float*)(C.lds + CV_SCR_OFF + C.wave * 8448);
    f32x4 v[3][8]; P0It it[3];
#define CV3_DEC(i_) CV_DECODE(C, (jq0 + ((i_) >> 1)) >> 2, C.wave + 8 * (2 * ((jq0 + ((i_) >> 1)) & 3) + ((i_) & 1)))
    it[0] = CV3_DEC(0); CV_LOAD(it[0], v[0], C.lane);
    it[1] = CV3_DEC(1); CV_LOAD(it[1], v[1], C.lane);
#pragma unroll
    for (int i = 0; i < 6; ++i) {
        const int ip = (i + 2 < 6) ? i + 2 : 5;
        it[(i + 2) % 3] = CV3_DEC(ip); CV_LOAD(it[(i + 2) % 3], v[(i + 2) % 3], C.lane);
        CV_STORE(it[i % 3], v[i % 3], scr, C.lane);
    }
#undef CV3_DEC
}
__device__ __forceinline__ int attn_build_items(const Ctx& C, float thr2, LAS unsigned* items) {
    LAS float* cb = (LAS float*)(C.lds + CV_SCR_OFF);
    LAS int* wcnt = (LAS int*)(C.lds + P2_MISC_OFF);
    LAS int* woff = wcnt + 8 * 33;
    const float* c2 = WSP(float, WS_C2);
    { float t_[4];
#pragma unroll
      for (int i = 0; i < 4; ++i) { const int idx = C.tid + i * NWAVES * 64; t_[i] = c2[(size_t)(idx >> 6) * SEQ + (idx & 63) * 64 + 63]; }
#pragma unroll
      for (int i = 0; i < 4; ++i) cb[C.tid + i * NWAVES * 64] = t_[i]; }
    __syncthreads();
    const int u = C.tid, bh = u >> 4, qb = u & 15, NTl = 4 * (qb + 1);
    const float cq0 = c2[(size_t)bh * SEQ + qb * 256];
    int ts = 0;
#pragma unroll 1
    for (int i = 0; i < NTl; ++i) ts = (cq0 - cb[bh * 64 + i] < thr2) ? i + 1 : ts;
    if (ts >= NTl) ts = NTl - 1;
    const int n = NTl - ts, split = n > 32 ? 1 : 0, n0 = split ? (n + 1) / 2 : n;
    const int costA = n0, costB = n - n0;
    const unsigned itemA = (unsigned)u | ((unsigned)split << 10) | ((unsigned)ts << 11) | ((unsigned)(ts + n0) << 18);
    const unsigned itemB = (unsigned)u | (1u << 9) | (1u << 10) | ((unsigned)(ts + n0) << 11) | ((unsigned)NTl << 18);
    const unsigned long long ltmask = (1ull << C.lane) - 1ull;
#pragma unroll 1
    for (int c = 0; c <= 32; ++c) { const unsigned long long bA = __ballot(costA == c), bB = __ballot(costB == c); if (C.lane == 0) wcnt[C.wave * 33 + c] = __popcll(bA) + __popcll(bB); }
    __syncthreads();
    if (C.tid < 8 * 33) { const int w = C.tid / 33, c = C.tid % 33; int off = 0;
        for (int c2_ = 32; c2_ > c; --c2_) for (int w2 = 0; w2 < 8; ++w2) off += wcnt[w2 * 33 + c2_];
        for (int w2 = 0; w2 < w; ++w2) off += wcnt[w2 * 33 + c];
        woff[C.tid] = off; }
    __syncthreads();
    int posA = 0, posB = 0;
#pragma unroll 1
    for (int c = 0; c <= 32; ++c) { const unsigned long long bA = __ballot(costA == c), bB = __ballot(costB == c); const int base = woff[C.wave * 33 + c];
        if (costA == c) posA = base + __popcll(bA & ltmask);
        if (costB == c) posB = base + __popcll(bA) + __popcll(bB & ltmask); }
    if (costA > 0) items[posA] = itemA;
    if (costB > 0) items[posB] = itemB;
    const int NA = woff[0];
    const int NBIG = woff[CV_COST - 1];
    __syncthreads();
    return NA | (NBIG << 16);
}
__device__ __forceinline__ void attn_phase(const Ctx& C) {
    const float qm = wave_max(fabsf(C.in[11][C.lane])), km = wave_max(fabsf(C.in[12][C.lane]));
    const float smax = 8.0f * qm * km * 1.05f;
    const float thr2 = -(104.0f + 2.0f * smax) * LOG2E, sref = smax * LOG2E;
    LAS unsigned* items = (LAS unsigned*)(C.lds + P2_LIST_OFF);
    LAS int* qn = (LAS int*)(C.lds + P2_MISC_OFF + 2304);
    const int nab_ = attn_build_items(C, thr2, items), NA = nab_ & 0xffff, NBIG = nab_ >> 16;
    unsigned* qctr = (unsigned*)(C.ws + WS_CTL) + CW_QUEUE;
    if (C.tid == 0) qn[0] = (int)__hip_atomic_fetch_add(qctr, 1u, __ATOMIC_RELAXED, __HIP_MEMORY_SCOPE_AGENT);
    __syncthreads();
    int cur = qn[0];
#ifdef CONV_IN_P0
    const int ncv_ = 0;
#else
    const int ncv_ = (C.G == 256) ? NCV : NCV_ALL;
#endif
    while (cur < NA + ncv_) {
        int nxt = 0;
        if (C.tid == 0) nxt = (int)__hip_atomic_fetch_add(qctr, 1u, __ATOMIC_RELAXED, __HIP_MEMORY_SCOPE_AGENT);
        if (cur < NBIG) attn_item(C, items[cur], sref); else if (cur < NBIG + ncv_) conv_item(C, cur - NBIG); else attn_item(C, items[cur - ncv_], sref);
        __syncthreads();
        if (C.tid == 0) qn[0] = nxt;
        __syncthreads();
        cur = qn[0];
    }
}

struct PostRow { v4u hp0, hp1; v4u gw, aw, aw1; float lp0, lp1; };
__device__ __forceinline__ void post_load(const Ctx& C, PostRow& R, size_t row, int c8, int lane) {
    const unsigned* HP = WSP(unsigned, WS_HLOC); const bf16* GG = WSP(bf16, WS_GG); const bf16* ATT = WSP(bf16, WS_ATT); const bf16* ATT1 = WSP(bf16, WS_ATT1);
    R.hp0 = *(const v4u*)(HP + row * 512 + c8); R.hp1 = *(const v4u*)(HP + row * 512 + c8 + 4);
    R.gw = *(const v4u*)(GG + row * 512 + c8); R.aw = *(const v4u*)(ATT + row * 512 + c8); R.aw1 = *(const v4u*)(ATT1 + row * 512 + c8);
    R.lp0 = WSP(float, WS_L0)[row * NH + (lane >> 3)]; R.lp1 = WSP(float, WS_L1)[row * NH + (lane >> 3)];
}
__device__ __forceinline__ void post_phase(const Ctx& C, int unit) {
    const int b = unit >> 6, ch = unit & 63;
    LAS float* CA = (LAS float*)C.lds;
    LAS float* CB = CA + 8 * 512;
    LAS float* Hc = CB + 8 * 512;
    const int c8 = 8 * C.lane;
    {
        const float* A = WSP(float, WS_AEND) + (size_t)b * NCHUNK * 512 + c8; const float* B = WSP(float, WS_BEND) + (size_t)b * NCHUNK * 512 + c8;
        f32x4 a0 = {1.f, 1.f, 1.f, 1.f}, a1 = a0, b0 = {0.f, 0.f, 0.f, 0.f}, b1 = b0;
        f32x4 va[8][2], vb[8][2];
#pragma unroll
        for (int i = 0; i < 8; ++i) { const int k = 8 * C.wave + i, kc = k < ch ? k : 0;
            va[i][0] = *(const f32x4*)(A + (size_t)kc * 512); va[i][1] = *(const f32x4*)(A + (size_t)kc * 512 + 4); vb[i][0] = *(const f32x4*)(B + (size_t)kc * 512); vb[i][1] = *(const f32x4*)(B + (size_t)kc * 512 + 4); }
#pragma unroll
        for (int i = 0; i < 8; ++i) { if (8 * C.wave + i < ch) { b0 = va[i][0] * b0 + vb[i][0]; b1 = va[i][1] * b1 + vb[i][1]; a0 = a0 * va[i][0]; a1 = a1 * va[i][1]; } }
        *(LAS f32x4*)(CA + C.wave * 512 + c8) = a0; *(LAS f32x4*)(CA + C.wave * 512 + c8 + 4) = a1; *(LAS f32x4*)(CB + C.wave * 512 + c8) = b0; *(LAS f32x4*)(CB + C.wave * 512 + c8 + 4) = b1;
    }
    __syncthreads();
    { float H = 0.f;
#pragma unroll
      for (int w = 0; w < 8; ++w) H = CA[w * 512 + C.tid] * H + CB[w * 512 + C.tid];
      Hc[C.tid] = H; }
    __syncthreads();
    bf16* MIX = WSP(bf16, WS_MIX);
    const f32x4 h0 = *(const LAS f32x4*)(Hc + c8), h1 = *(const LAS f32x4*)(Hc + c8 + 4);
    const f32x4 wr0 = *(const f32x4*)(C.in[13] + c8), wr1 = *(const f32x4*)(C.in[13] + c8 + 4), wa0 = *(const f32x4*)(C.in[14] + c8), wa1 = *(const f32x4*)(C.in[14] + c8 + 4);
    const size_t rowb = (size_t)b * SEQ + ch * CHUNK + C.wave * 8;
    PostRow R, Rn; post_load(C, R, rowb, c8, C.lane);
#pragma unroll 1
    for (int i = 0; i < 8; ++i) {
        const size_t row = rowb + i;
        post_load(C, Rn, rowb + (i < 7 ? i + 1 : 7), c8, C.lane);
        const float rl01 = 1.0f / (R.lp0 + R.lp1), f0 = R.lp0 * rl01, f1 = R.lp1 * rl01;
        f32x4 r0 = {bflo(R.hp0.x) + bfhi(R.hp0.x) * h0.x, bflo(R.hp0.y) + bfhi(R.hp0.y) * h0.y, bflo(R.hp0.z) + bfhi(R.hp0.z) * h0.z, bflo(R.hp0.w) + bfhi(R.hp0.w) * h0.w};
        f32x4 r1 = {bflo(R.hp1.x) + bfhi(R.hp1.x) * h1.x, bflo(R.hp1.y) + bfhi(R.hp1.y) * h1.y, bflo(R.hp1.z) + bfhi(R.hp1.z) * h1.z, bflo(R.hp1.w) + bfhi(R.hp1.w) * h1.w};
        r0.x *= bflo(R.gw.x); r0.y *= bfhi(R.gw.x); r0.z *= bflo(R.gw.y); r0.w *= bfhi(R.gw.y); r1.x *= bflo(R.gw.z); r1.y *= bfhi(R.gw.z); r1.z *= bflo(R.gw.w); r1.w *= bfhi(R.gw.w);
        float ss = (r0.x * r0.x + r0.y * r0.y) + (r0.z * r0.z + r0.w * r0.w) + (r1.x * r1.x + r1.y * r1.y) + (r1.z * r1.z + r1.w * r1.w);
        f32x4 a0 = {bflo(R.aw.x), bfhi(R.aw.x), bflo(R.aw.y), bfhi(R.aw.y)}, a1 = {bflo(R.aw.z), bfhi(R.aw.z), bflo(R.aw.w), bfhi(R.aw.w)};
        a0 = a0 * f0; a1 = a1 * f0;
        if (R.lp1 > 0.f) { const f32x4 q0 = {bflo(R.aw1.x), bfhi(R.aw1.x), bflo(R.aw1.y), bfhi(R.aw1.y)}, q1 = {bflo(R.aw1.z), bfhi(R.aw1.z), bflo(R.aw1.w), bfhi(R.aw1.w)}; a0 += q0 * f1; a1 += q1 * f1; }
        float sa = (a0.x * a0.x + a0.y * a0.y) + (a0.z * a0.z + a0.w * a0.w) + (a1.x * a1.x + a1.y * a1.y) + (a1.z * a1.z + a1.w * a1.w);
        const float rs = 1.0f / sqrtf(wave_sum(ss) * (1.0f / DREC) + EPS), ra = 1.0f / sqrtf(wave_sum(sa) * (1.0f / DATT) + EPS);
        r0 = r0 * rs * wr0; r1 = r1 * rs * wr1; a0 = a0 * ra * wa0; a1 = a1 * ra * wa1;
        *(v4u*)(MIX + row * DM + c8) = (v4u){cvtpk(r0.x, r0.y), cvtpk(r0.z, r0.w), cvtpk(r1.x, r1.y), cvtpk(r1.z, r1.w)};
        *(v4u*)(MIX + row * DM + 512 + c8) = (v4u){cvtpk(a0.x, a0.y), cvtpk(a0.z, a0.w), cvtpk(a1.x, a1.y), cvtpk(a1.z, a1.w)};
        R = Rn;
    }
    __syncthreads();
}

struct EpiRes {
    static constexpr bool PERM = true, AFTER_DRAIN = false;
    const float* x; bf16* x1b; unsigned char* xb; const float* ln2;
    __device__ __forceinline__ void operator()(const pg8::f32x4 (&acc)[2][2][4][2], const pg8::Unit& u, int wr, int wc, int fr, int fq) const {
        const int row0 = u.pm * 256 + wr * 64 + fr, col0 = u.pn * 256 + wc * 32 + 8 * fq;
        pg8::f32x4 lw[2][2];
#pragma unroll
        for (int bj = 0; bj < 2; ++bj)
#pragma unroll
            for (int n = 0; n < 2; ++n) lw[bj][n] = *(const pg8::f32x4*)(ln2 + col0 + bj * 128 + 4 * n);
#pragma unroll
        for (int ai = 0; ai < 2; ++ai)
#pragma unroll
            for (int m = 0; m < 4; ++m) { const size_t off = (size_t)(row0 + ai * 128 + m * 16) * DM + col0;
#pragma unroll
                for (int bj = 0; bj < 2; ++bj) { u32x2 w; v4u xw;
#pragma unroll
                    for (int n = 0; n < 2; ++n) { const pg8::f32x4 xv = *(const pg8::f32x4*)(x + off + bj * 128 + 4 * n) + acc[ai][bj][m][n]; xw[2 * n] = cvtpk(xv[0], xv[1]); xw[2 * n + 1] = cvtpk(xv[2], xv[3]);
                        const pg8::f32x4 q = xv * lw[bj][n]; w[n] = pk_fp8x4(q[0], q[1], q[2], q[3]); }
                    *(v4u*)(x1b + off + bj * 128) = xw; *(u32x2*)(xb + off + bj * 128) = w; } }
    }
};

__device__ __forceinline__ void split_bf16x8(const float (&v)[8], bf16x8& h, bf16x8& l) {
    v4u ph, pl;
#pragma unroll
    for (int i = 0; i < 4; ++i) { const unsigned p = cvtpk(v[2 * i], v[2 * i + 1]); ph[i] = p; pl[i] = cvtpk(v[2 * i] - bflo(p), v[2 * i + 1] - bfhi(p)); }
    h = __builtin_bit_cast(bf16x8, ph); l = __builtin_bit_cast(bf16x8, pl);
}
__device__ __forceinline__ void router_phase(const Ctx& C, bool dry = false) {
    LAS float* PART = (LAS float*)C.lds;
    LAS float* SSP = PART + 8 * 64 * 32;
    LAS float* LG = SSP + 8 * 64;
    LAS int* lcnt = (LAS int*)(C.lds + TAB_OFF);
    LAS int* gbase = lcnt + 32;
    LAS int* te = gbase + 32;
    LAS int* tp = te + 256;
    LAS float* tg = (LAS float*)(tp + 256);
    if (C.tid < 32) lcnt[C.tid] = 0;
    __syncthreads();
    const bf16* x1 = WSP(bf16, WS_X1B); const float* br = C.in[18]; const float* wr = C.in[17]; const float* ln2 = C.in[16];
    const size_t dofs = dry ? (size_t)(700 * MiB) : 0;
    float* RSTD2 = (float*)(C.ws + WS_RSTD2 + dofs); int* TKE = (int*)(C.ws + WS_TKE + dofs); int* TKP = (int*)(C.ws + WS_TKP + dofs); float* TKG = (float*)(C.ws + WS_TKG + dofs);
    unsigned* cnt = (unsigned*)(C.ws + WS_CTL + dofs) + CW_CNT;
    const int w = C.wave, l32 = C.lane & 31, hi = C.lane >> 5;
    for (int unit = C.vcu; unit < M / 64; unit += C.G) {
        const int t0 = unit * 64;
        f32x16 acc0 = {}, acc1 = {}; float ss0 = 0.f, ss1 = 0.f;
#pragma unroll
        for (int ks = 0; ks < 8; ++ks) {
            const int d0 = 128 * w + 16 * ks + 8 * hi;
            float bw[8];
            { const float* wp = wr + (size_t)d0 * NE + l32; const f32x4 la = *(const f32x4*)(ln2 + d0), lb = *(const f32x4*)(ln2 + d0 + 4);
              bw[0] = wp[0] * la.x; bw[1] = wp[32] * la.y; bw[2] = wp[64] * la.z; bw[3] = wp[96] * la.w; bw[4] = wp[128] * lb.x; bw[5] = wp[160] * lb.y; bw[6] = wp[192] * lb.z; bw[7] = wp[224] * lb.w; }
            bf16x8 wh, wl; split_bf16x8(bw, wh, wl);
            { const v4u raw = *(const v4u*)(x1 + (size_t)(t0 + l32) * DM + d0);
              const float av[8] = {bflo(raw.x), bfhi(raw.x), bflo(raw.y), bfhi(raw.y), bflo(raw.z), bfhi(raw.z), bflo(raw.w), bfhi(raw.w)};
#pragma unroll
              for (int j = 0; j < 8; ++j) ss0 += av[j] * av[j];
              const bf16x8 xh = __builtin_bit_cast(bf16x8, raw);
              acc0 = __builtin_amdgcn_mfma_f32_32x32x16_bf16(xh, wh, acc0, 0, 0, 0); acc0 = __builtin_amdgcn_mfma_f32_32x32x16_bf16(xh, wl, acc0, 0, 0, 0); }
            { const v4u raw = *(const v4u*)(x1 + (size_t)(t0 + 32 + l32) * DM + d0);
              const float av[8] = {bflo(raw.x), bfhi(raw.x), bflo(raw.y), bfhi(raw.y), bflo(raw.z), bfhi(raw.z), bflo(raw.w), bfhi(raw.w)};
#pragma unroll
              for (int j = 0; j < 8; ++j) ss1 += av[j] * av[j];
              const bf16x8 xh = __builtin_bit_cast(bf16x8, raw);
              acc1 = __builtin_amdgcn_mfma_f32_32x32x16_bf16(xh, wh, acc1, 0, 0, 0); acc1 = __builtin_amdgcn_mfma_f32_32x32x16_bf16(xh, wl, acc1, 0, 0, 0); }
        }
#pragma unroll
        for (int r = 0; r < 16; ++r) { PART[(w * 64 + crow(r, hi)) * 32 + l32] = acc0[r]; PART[(w * 64 + 32 + crow(r, hi)) * 32 + l32] = acc1[r]; }
        ss0 += __shfl_xor(ss0, 32); ss1 += __shfl_xor(ss1, 32);
        if (hi == 0) { SSP[w * 64 + l32] = ss0; SSP[w * 64 + 32 + l32] = ss1; }
        __syncthreads();
        { const int tl = C.tid >> 3, e4 = C.tid & 7; f32x4 s = {0.f, 0.f, 0.f, 0.f}; float sq = 0.f;
#pragma unroll
          for (int w2 = 0; w2 < 8; ++w2) { s += *(const LAS f32x4*)(PART + (w2 * 64 + tl) * 32 + 4 * e4); sq += SSP[w2 * 64 + tl]; }
          const float rstd = 1.0f / sqrtf(sq * (1.0f / DM) + EPS); const f32x4 bb = *(const f32x4*)(br + 4 * e4);
          LG[tl * 33 + 4 * e4] = s.x * rstd + bb.x; LG[tl * 33 + 4 * e4 + 1] = s.y * rstd + bb.y; LG[tl * 33 + 4 * e4 + 2] = s.z * rstd + bb.z; LG[tl * 33 + 4 * e4 + 3] = s.w * rstd + bb.w;
          if (e4 == 0) RSTD2[t0 + tl] = rstd; }
        __syncthreads();
        if (C.tid < 64) {
            const int tl = C.tid; float lg[32];
#pragma unroll
            for (int e = 0; e < 32; ++e) lg[e] = LG[tl * 33 + e];
            float tv[4]; int ti[4];
#pragma unroll
            for (int k = 0; k < 4; ++k) { float best = -INFINITY; int bi = 0;
#pragma unroll
                for (int e = 0; e < 32; ++e) { const bool gt = lg[e] > best; best = gt ? lg[e] : best; bi = gt ? e : bi; }
                tv[k] = best; ti[k] = bi;
#pragma unroll
                for (int e = 0; e < 32; ++e) lg[e] = (e == bi) ? -INFINITY : lg[e]; }
            const float e1 = fast_exp(tv[1] - tv[0]), e2 = fast_exp(tv[2] - tv[0]), e3 = fast_exp(tv[3] - tv[0]); const float inv = 1.0f / (1.0f + e1 + e2 + e3);
            const float gk[4] = {inv, e1 * inv, e2 * inv, e3 * inv};
#pragma unroll
            for (int k = 0; k < 4; ++k) { const int lp = __hip_atomic_fetch_add(lcnt + ti[k], 1, __ATOMIC_RELAXED, __HIP_MEMORY_SCOPE_WORKGROUP); te[tl * 4 + k] = ti[k]; tp[tl * 4 + k] = lp; }
            *(f32x4*)(TKG + (size_t)(t0 + tl) * 4) = (f32x4){gk[0], gk[1], gk[2], gk[3]};
#pragma unroll
            for (int k = 0; k < 4; ++k) tg[tl * 4 + k] = gk[k];
        }
        __syncthreads();
        if (C.tid < 32) { gbase[C.tid] = (int)__hip_atomic_fetch_add(cnt + 64 * C.tid, (unsigned)lcnt[C.tid], __ATOMIC_RELAXED, __HIP_MEMORY_SCOPE_AGENT); }
        __syncthreads();
        if (C.tid < 256) { const int e = te[C.tid], pos = gbase[e] + tp[C.tid]; TKE[(size_t)unit * 256 + C.tid] = e; TKP[(size_t)unit * 256 + C.tid] = pos;
            if (!dry) { WSP(int, WS_LIST)[(size_t)e * M + pos] = t0 + (C.tid >> 2); WSP(float, WS_LISTG)[(size_t)e * M + pos] = tg[C.tid]; } }
        __syncthreads();
        if (C.tid < 32) lcnt[C.tid] = 0;
        __syncthreads();
    }
}

__device__ __forceinline__ void build_tables(const Ctx& C) {
    LAS int* padstart = (LAS int*)(C.lds + TAB_OFF);
    LAS int* tile_e = padstart + 40;
    const unsigned* cnt = (const unsigned*)(C.ws + WS_CTL) + CW_CNT;
    LAS int* cntl = padstart + 40 + MAXMT;
    if (C.tid < NE) cntl[C.tid] = (int)__hip_atomic_load(cnt + 64 * C.tid, __ATOMIC_RELAXED, __HIP_MEMORY_SCOPE_AGENT);
    __syncthreads();
    if (C.tid == 0) { int acc = 0; for (int e = 0; e < NE; ++e) { padstart[e] = acc; acc += (cntl[e] + 255) & ~255; } padstart[NE] = acc; }
    __syncthreads();
    if (C.tid < MAXMT) { const int r = C.tid * 256; int e = 0;
#pragma unroll 1
        for (int k = 1; k < NE; ++k) e = (padstart[k] <= r) ? k : e;
        tile_e[C.tid] = e; }
    __syncthreads();
}

struct GRow { f32x4 x[4]; float rstd; int e[4], p[4]; f32x4 g; };
__device__ __forceinline__ void gather_load(const Ctx& C, GRow& R, int t) {
    const f32x4* xr = (const f32x4*)(C.out + (size_t)t * DM) + C.lane;
#pragma unroll
    for (int jj = 0; jj < 4; ++jj) R.x[jj] = xr[64 * jj];
    R.rstd = WSP(float, WS_RSTD2)[t];
    const v4u ev = *(const v4u*)(WSP(int, WS_TKE) + (size_t)t * 4), pv = *(const v4u*)(WSP(int, WS_TKP) + (size_t)t * 4);
    R.e[0] = ev.x; R.e[1] = ev.y; R.e[2] = ev.z; R.e[3] = ev.w; R.p[0] = pv.x; R.p[1] = pv.y; R.p[2] = pv.z; R.p[3] = pv.w;
    R.g = *(const f32x4*)(WSP(float, WS_TKG) + (size_t)t * 4);
}
__device__ __forceinline__ void gather_phase(const Ctx& C) {
    const LAS int* padstart = (const LAS int*)(C.lds + TAB_OFF);
    const float* ln2 = C.in[16];
    unsigned char* XS = C.ws + WS_XS; float* SLOTG = WSP(float, WS_SLOTG);
    f32x4 w[4];
#pragma unroll
    for (int jj = 0; jj < 4; ++jj) w[jj] = *(const f32x4*)(ln2 + 4 * C.lane + 256 * jj);
    const int gw = C.vcu * NWAVES + C.wave, NGW = C.G * NWAVES;
    GRow R, Rn; gather_load(C, R, gw < M ? gw : M - 1);
    for (int t = gw; t < M; t += NGW) {
        gather_load(C, Rn, (t + NGW < M) ? t + NGW : t);
        unsigned pk[4];
#pragma unroll
        for (int jj = 0; jj < 4; ++jj) { const f32x4 v = R.x[jj] * R.rstd * w[jj]; pk[jj] = pk_fp8x4(v.x, v.y, v.z, v.w); }
        const float gk[4] = {R.g.x, R.g.y, R.g.z, R.g.w};
#pragma unroll
        for (int k = 0; k < 4; ++k) { const int slot = padstart[R.e[k]] + R.p[k];
            unsigned* o4 = (unsigned*)(XS + (size_t)slot * DM) + C.lane;
#pragma unroll
            for (int jj = 0; jj < 4; ++jj) o4[64 * jj] = pk[jj];
            if (C.lane == 0) SLOTG[slot] = gk[k]; }
        R = Rn;
    }
}


__device__ __forceinline__ int fresh_lane() { int l = __builtin_amdgcn_mbcnt_hi(~0u, __builtin_amdgcn_mbcnt_lo(~0u, 0u)); asm volatile("" : "+v"(l)); return l; }
constexpr float WSCALE_INV = 1.0f / 32.0f, HSCALE = 4.0f;
struct MoeOrder {
    int nM, nN, nwg, G, c; const LAS int* tile_e;
    __device__ __forceinline__ bool next(int i, pg8::Unit& u) const {
        const long L = (long)i * G + c; if (L >= nwg) return false;
        int wgid = (int)L; { const int q = nwg / 8, r = nwg % 8, xcd = wgid % 8, off = wgid / 8; wgid = (xcd < r ? xcd * (q + 1) : r * (q + 1) + (xcd - r) * q) + off; }
        const int nig = 8 * nN, gid = wgid / nig, fm = gid * 8, gsz = (nM - fm) < 8 ? (nM - fm) : 8;
        const int pm = fm + ((wgid % nig) % gsz), pnl = (wgid % nig) / gsz;
        u.pm = pm; u.pn = tile_e[pm] * nN + pnl; return true;
    }
    __device__ __forceinline__ void a_ready(const pg8::Unit&) const {}
    __device__ __forceinline__ void done(const pg8::Unit&) const {}
};
constexpr int TOKT_OFF = 131072, TOKR_OFF = TOKT_OFF + 10 * 1024;
struct MoeGatherOrder {
    int nM, nN, nwg, G, c; const LAS int* tile_e; const LAS int* tokt;
    __device__ __forceinline__ bool next(int i, pg8::Unit& u) const {
        const long L = (long)i * G + c; if (L >= nwg) return false;
        int wgid = (int)L; { const int q = nwg / 8, r = nwg % 8, xcd = wgid % 8, off = wgid / 8; wgid = (xcd < r ? xcd * (q + 1) : r * (q + 1) + (xcd - r) * q) + off; }
        const int nig = 8 * nN, gid = wgid / nig, fm = gid * 8, gsz = (nM - fm) < 8 ? (nM - fm) : 8;
        const int pm = fm + ((wgid % nig) % gsz), pnl = (wgid % nig) / gsz;
        u.pm = pm; u.pn = (i << 16) | (tile_e[pm] * nN + pnl); return true;
    }
    __device__ __forceinline__ int arow(int ui, int r) const { return tokt[ui * 256 + r]; }
    __device__ __forceinline__ void a_ready(const pg8::Unit&) const {}
    __device__ __forceinline__ void done(const pg8::Unit&) const {}
};
__device__ __forceinline__ void fill_unit_tables(const Ctx& C, const MoeGatherOrder& S) {
    const LAS int* padstart = (const LAS int*)(C.lds + TAB_OFF); const LAS int* cntl = padstart + 40 + MAXMT;
    LAS int* tokt = (LAS int*)(C.lds + TOKT_OFF); LAS float* tokr = (LAS float*)(C.lds + TOKR_OFF);
    const int* LIST = WSP(int, WS_LIST); const float* RSTD2 = WSP(float, WS_RSTD2);
    if (C.tid < 256) {
        int tok[10]; float rs[10]; bool ok[10];
        pg8::Unit u;
#pragma unroll
        for (int i = 0; i < 10; ++i) { ok[i] = S.next(i, u); const int pm = ok[i] ? u.pm : 0; const int e = S.tile_e[pm], idx = pm * 256 - padstart[e] + C.tid; tok[i] = LIST[(size_t)e * M + ((ok[i] && idx < cntl[e]) ? idx : 0)]; }
#pragma unroll
        for (int i = 0; i < 10; ++i) rs[i] = RSTD2[tok[i]];
#pragma unroll
        for (int i = 0; i < 10; ++i) if (ok[i]) { tokt[i * 256 + C.tid] = tok[i]; tokr[i * 256 + C.tid] = rs[i]; }
    }
    __syncthreads();
}
struct EpiGateUp {
    static constexpr bool PERM = true, AFTER_DRAIN = false;
    unsigned char* H; const float* bgu; const LAS float* tokr;
    __device__ __forceinline__ void operator()(const pg8::f32x4 (&acc)[2][2][4][2], const pg8::Unit& u, int wr, int wc, int, int) const {
        const int l_ = fresh_lane(), fr = l_ & 15, fq = l_ >> 4;
        const int ui = u.pn >> 16, en = u.pn & 0xffff, e = en >> 3, pnl = en & 7, rl0 = wr * 64 + fr, row0 = u.pm * 256 + rl0, col0 = 128 * pnl + 32 * wc + 8 * fq;
        const float* bg = bgu + (size_t)e * 2048 + col0;
        pg8::f32x4 bgv[2], buv[2];
#pragma unroll
        for (int n = 0; n < 2; ++n) { bgv[n] = *(const pg8::f32x4*)(bg + 4 * n); buv[n] = *(const pg8::f32x4*)(bg + 1024 + 4 * n); }
#pragma unroll
        for (int ai = 0; ai < 2; ++ai)
#pragma unroll
            for (int m = 0; m < 4; ++m) { unsigned char* rowp = H + (size_t)(row0 + ai * 128 + m * 16) * DM + col0; u32x2 w; const float rs = tokr[ui * 256 + rl0 + ai * 128 + m * 16] * WSCALE_INV;
#pragma unroll
                for (int n = 0; n < 2; ++n) {
                    pg8::f32x4 g = acc[ai][0][m][n] * rs + bgv[n], uu = acc[ai][1][m][n] * rs + buv[n];
#pragma unroll
                    for (int j = 0; j < 4; ++j) { g[j] = fminf(g[j], 7.0f); uu[j] = __builtin_amdgcn_fmed3f(uu[j], -7.0f, 7.0f); }
                    pg8::f32x4 ex = g * (-1.702f * LOG2E);
#pragma unroll
                    for (int j = 0; j < 4; ++j) ex[j] = __builtin_amdgcn_exp2f(ex[j]);
                    pg8::f32x4 den = ex + 1.0f;
#pragma unroll
                    for (int j = 0; j < 4; ++j) den[j] = __builtin_amdgcn_rcpf(den[j]);
                    const pg8::f32x4 a = (uu * HSCALE + HSCALE) * (g * den);
                    w[n] = pk_fp8x4(a[0], a[1], a[2], a[3]); }
                *(u32x2*)rowp = w; }
    }
};
constexpr float YSCALE = 16.0f;
struct EpiDown {
    static constexpr bool PERM = true, AFTER_DRAIN = false;
    unsigned char* Y; const float* bd; const float* listg; const LAS int* padstart;
    __device__ __forceinline__ void operator()(const pg8::f32x4 (&acc)[2][2][4][2], const pg8::Unit& u, int wr, int wc, int, int) const {
        const int l_ = fresh_lane(), fr = l_ & 15, fq = l_ >> 4;
        const int e = u.pn >> 2, pnl = u.pn & 3, row0 = u.pm * 256 + wr * 64 + fr, col0 = 256 * pnl + 32 * wc + 8 * fq;
        const float* bp = bd + (size_t)e * DM + col0;
        const int ps = padstart[e], ce = padstart[40 + MAXMT + e]; const float* lg = listg + (size_t)e * M;
        pg8::f32x4 bv[2][2];
#pragma unroll
        for (int bj = 0; bj < 2; ++bj)
#pragma unroll
            for (int n = 0; n < 2; ++n) bv[bj][n] = *(const pg8::f32x4*)(bp + 128 * bj + 4 * n);
#pragma unroll
        for (int ai = 0; ai < 2; ++ai)
#pragma unroll
            for (int m = 0; m < 4; ++m) { const int row = row0 + ai * 128 + m * 16, idx = row - ps; const float gt = (idx < ce ? lg[idx] : 0.f) * YSCALE; unsigned char* rowp = Y + (size_t)row * DM + col0;
#pragma unroll
                for (int bj = 0; bj < 2; ++bj) { const pg8::f32x4 v0 = (acc[ai][bj][m][0] * (WSCALE_INV / HSCALE) + bv[bj][0]) * gt, v1 = (acc[ai][bj][m][1] * (WSCALE_INV / HSCALE) + bv[bj][1]) * gt;
                    *(u32x2*)(rowp + 128 * bj) = (u32x2){pk_fp8x4(v0[0], v0[1], v0[2], v0[3]), pk_fp8x4(v1[0], v1[1], v1[2], v1[3])}; } }
    }
};

struct CIdx { v4u e, p; u32x2 x[4]; };
__device__ __forceinline__ void comb_idx(const Ctx& C, CIdx& I, int t) {
    I.e = *(const v4u*)(WSP(int, WS_TKE) + (size_t)t * 4); I.p = *(const v4u*)(WSP(int, WS_TKP) + (size_t)t * 4);
    const u32x2* xr = (const u32x2*)(WSP(bf16, WS_X1B) + (size_t)t * DM) + C.lane;
#pragma unroll
    for (int jj = 0; jj < 4; ++jj) I.x[jj] = xr[64 * jj];
}
__device__ __forceinline__ void comb_ys(const Ctx& C, const CIdx& I, unsigned (&y)[4][4], const LAS int* padstart) {
    const unsigned char* YS = C.ws + WS_YS;
    const unsigned ev[4] = {I.e.x, I.e.y, I.e.z, I.e.w}, pv[4] = {I.p.x, I.p.y, I.p.z, I.p.w};
#pragma unroll
    for (int k = 0; k < 4; ++k) { const int slot = padstart[ev[k]] + (int)pv[k]; const unsigned* yp = (const unsigned*)(YS + (size_t)slot * DM) + C.lane;
#pragma unroll
        for (int jj = 0; jj < 4; ++jj) y[k][jj] = yp[64 * jj]; }
}
__device__ __forceinline__ void combine_phase(const Ctx& C, bool dry = false) {
    const LAS int* padstart = (const LAS int*)(C.lds + TAB_OFF);
    float* out = C.out;
    const int gw = C.vcu * NWAVES + C.wave, NGW = C.G * NWAVES;
    if (gw >= M) return;
    CIdx I0, I1; unsigned y0[4][4], y1[4][4];
    comb_idx(C, I0, gw); comb_ys(C, I0, y0, padstart); comb_idx(C, I1, (gw + NGW < M) ? gw + NGW : gw);
    for (int t = gw; t < M; t += NGW) {
        comb_ys(C, I1, y1, padstart);
        CIdx I2; comb_idx(C, I2, (t + 2 * NGW < M) ? t + 2 * NGW : t);
        f32x4 v[4];
#pragma unroll
        for (int jj = 0; jj < 4; ++jj) v[jj] = (f32x4){bflo(I0.x[jj].x), bfhi(I0.x[jj].x), bflo(I0.x[jj].y), bfhi(I0.x[jj].y)};
#pragma unroll
        for (int k = 0; k < 4; ++k)
#pragma unroll
            for (int jj = 0; jj < 4; ++jj) { const unsigned y = y0[k][jj]; const f32x2 lo = __builtin_amdgcn_cvt_pk_f32_fp8((int)y, false), hi = __builtin_amdgcn_cvt_pk_f32_fp8((int)y, true);
                v[jj].x += lo.x * (1.0f / YSCALE); v[jj].y += lo.y * (1.0f / YSCALE); v[jj].z += hi.x * (1.0f / YSCALE); v[jj].w += hi.y * (1.0f / YSCALE); }
        f32x4* xw = dry ? (f32x4*)(C.ws + 576 * MiB + (size_t)t * DM * 4) + C.lane : (f32x4*)(out + (size_t)t * DM) + C.lane;
#pragma unroll
        for (int jj = 0; jj < 4; ++jj) xw[64 * jj] = v[jj];
        I0 = I1; I1 = I2;
#pragma unroll
        for (int k = 0; k < 4; ++k)
#pragma unroll
            for (int jj = 0; jj < 4; ++jj) y0[k][jj] = y1[k][jj];
    }
}

struct Args { const float* in[23]; float* out; unsigned char* ws; int ph_lo, ph_hi; };
__global__ void __launch_bounds__(NWAVES * 64, 2) fwd_kernel(Args args) {
    extern __shared__ __attribute__((aligned(16))) unsigned char lds[];
    Ctx C;
    C.lds = (LAS unsigned char*)lds;
    C.tid = threadIdx.x; C.lane = C.tid & 63; C.wave = __builtin_amdgcn_readfirstlane(C.tid >> 6);
    C.G = gridDim.x; { const int bx = blockIdx.x; C.vcu = (C.G % 8 == 0) ? (bx % 8) * (C.G / 8) + bx / 8 : bx; }
#pragma unroll
    for (int i = 0; i < 23; ++i) C.in[i] = args.in[i];
    C.out = args.out; C.ws = args.ws;
    volatile LAS unsigned* MISC = (volatile LAS unsigned*)(C.lds + MISC_OFF);
    for (int u = C.tid; u < (LDS_BYTES - LDSCTL_OFF) / 4; u += NWAVES * 64) ((LAS unsigned*)(C.lds + LDSCTL_OFF))[u] = 0u;
    __syncthreads();
    XcdBarrier bar; bar.bar = (unsigned*)(C.ws + WS_CTL) + CW_BAR; bar.x = 0; bar.st = nullptr;
    if (N_LAUNCHES != PER_PHASE) bar = xcd_barrier_post((unsigned*)(C.ws + WS_CTL) + CW_BAR, MISC + 8);
    const int lo = args.ph_lo, hi = args.ph_hi;
#ifndef PHASE_MASK
#define PHASE_MASK 0x3ff
#endif
#define IN(k) (((PHASE_MASK >> (k)) & 1) && lo <= (k) && (k) < hi)
#define BOTH(k) (IN(k) && IN((k) + 1))
#define GRID_BAR() do { if (N_LAUNCHES != PER_PHASE) xcd_barrier(bar); } while (0)
#ifdef PROBE_K
    unsigned long long pr_a = 0, pr_b = 0;
#define PSTAMP(k) do { if ((k) == PROBE_K) pr_a = __builtin_amdgcn_s_memrealtime(); if ((k) == PROBE_K + 1) pr_b = __builtin_amdgcn_s_memrealtime(); } while (0)
#else
#define PSTAMP(k) do {} while (0)
#endif

#ifndef REP0
#define REP0 1
#endif
#ifndef REP2
#define REP2 1
#endif
#ifndef REP1
#define REP1 1
#endif
#ifndef REP3
#define REP3 1
#endif
#ifndef REP4
#define REP4 1
#endif
#ifndef REP6
#define REP6 1
#endif
#ifndef REP7
#define REP7 1
#endif
#ifndef REP8
#define REP8 1
#endif
    PSTAMP(0);
    if (IN(0)) { for (int rep = 0; rep < REP0; ++rep) { p0_prologue(C); __syncthreads(); }
#ifdef CONV_IN_P0
        for (int j = C.vcu; j < NCV; j += C.G) conv_item(C, j);
        __syncthreads();
#endif
        if (BOTH(0)) GRID_BAR(); }

    PSTAMP(1);
    if (IN(1)) {
#ifndef NO_CUMSUM
        p1_cumsum(C);
#endif
        pg8::Gemm g{WSP(bf16, WS_XN), WSP(bf16, WS_WIN), M, NPROJ, DM}; pg8::StaticOrder S; S.init(M, NPROJ, C.G, (int)blockIdx.x);
        EpiInProj E{WSP(bf16, WS_U), C.in[11], C.in[12]};
        for (int rep = 0; rep < REP1; ++rep) pg8::gemm_phase<EpiInProj, pg8::StaticOrder, true, true>(C.lds, g, S, E);
        if (C.G == 256 && (int)blockIdx.x >= 128) {
            conv_items3(C, NCV + NCV_P7 + ((int)blockIdx.x - 128) * 3);
        }
        if (BOTH(1)) GRID_BAR();
    }

    PSTAMP(2);
    if (IN(2)) {
      for (int rep = 0; rep < REP2; ++rep) {
#ifndef NO_LRU
#ifndef REPL
#define REPL 1
#endif
        for (int rl = 0; rl < REPL; ++rl) for (int u = C.vcu; u < BATCH * NCHUNK; u += C.G) lru_pass1(C, u);
#endif
#ifndef NO_ATTN
        attn_phase(C);
#endif
      }
        if (BOTH(2)) GRID_BAR();
    }

    PSTAMP(3);
    if (IN(3)) {
        for (int rep = 0; rep < REP3; ++rep) for (int u = C.vcu; u < BATCH * NCHUNK; u += C.G) post_phase(C, u);
        if (BOTH(3)) GRID_BAR();
    }

    PSTAMP(4);
    if (IN(4)) {
        pg8::Gemm g{WSP(bf16, WS_MIX), WSP(bf16, WS_WOUT), M, DM, DM}; pg8::StaticOrder S; S.init(M, DM, C.G, (int)blockIdx.x);
        EpiRes E{C.in[0], WSP(bf16, WS_X1B), C.ws + WS_XB, C.in[16]};
        for (int rep = 0; rep < REP4; ++rep) pg8::gemm_phase<EpiRes, pg8::StaticOrder, true, true>(C.lds, g, S, E);
        if (BOTH(4)) GRID_BAR();
    }

    PSTAMP(5);
#ifdef DRY5
    if (IN(5)) { router_phase(C, true); __syncthreads(); }
#endif
    if (IN(5)) { router_phase(C); if (BOTH(5)) GRID_BAR(); }

    PSTAMP(6);

    PSTAMP(7);
    if (IN(7)) {
        build_tables(C);
        const LAS int* padstart = (const LAS int*)(C.lds + TAB_OFF); const int MT = padstart[NE] >> 8;
        pg8::Gemm g{(const bf16*)(C.ws + WS_XB), WSP(bf16, WS_WGU), M, NE * 2048, DM / 2};
        MoeGatherOrder S{MT, 8, MT * 8, C.G, (int)blockIdx.x, padstart + 40, (const LAS int*)(C.lds + TOKT_OFF)};
        fill_unit_tables(C, S);
        EpiGateUp E{C.ws + WS_HB, C.in[20], (const LAS float*)(C.lds + TOKR_OFF)};
        for (int rep = 0; rep < REP7; ++rep) pg8::gemm_phase<EpiGateUp, MoeGatherOrder, true, true, true, true>(C.lds, g, S, E);
        if (C.G == 256) {
            LAS int* qd = (LAS int*)(C.lds + P2_MISC_OFF + 2304);
            unsigned* dctr = (unsigned*)(C.ws + WS_CTL) + CW_DEFER;
            for (;;) {
                __syncthreads();
                if (C.tid == 0) qd[0] = (int)__hip_atomic_fetch_add(dctr, 1u, __ATOMIC_RELAXED, __HIP_MEMORY_SCOPE_AGENT);
                __syncthreads();
                const int idx = ((volatile LAS int*)qd)[0];
                if (idx >= NCV_P7) break;
                conv_item(C, NCV + idx);
            }
        }
        if (BOTH(7)) GRID_BAR();
    }

    PSTAMP(8);
    if (IN(8)) {
        if (!IN(7)) build_tables(C);
        const LAS int* padstart = (const LAS int*)(C.lds + TAB_OFF); const int MT = padstart[NE] >> 8;
        pg8::Gemm g{WSP(bf16, WS_HB), WSP(bf16, WS_WDN), MAXSLOT, NE * DM, DM / 2};
        MoeOrder S{MT, 4, MT * 4, C.G, (int)blockIdx.x, padstart + 40};
        EpiDown E{C.ws + WS_YS, C.in[22], WSP(float, WS_LISTG), padstart};
        for (int rep = 0; rep < REP8; ++rep) pg8::gemm_phase<EpiDown, MoeOrder, true, true, true>(C.lds, g, S, E);
        if (BOTH(8)) GRID_BAR();
    }

    PSTAMP(9);
    if (IN(9)) {
        if (!IN(7) && !IN(8)) build_tables(C);
#ifdef DRY9
        combine_phase(C, true);
#endif
        combine_phase(C);
    }
    PSTAMP(10);
#ifdef PROBE_K
    { const unsigned long long d = pr_b - pr_a, t_end = __builtin_amdgcn_s_memrealtime(); while (__builtin_amdgcn_s_memrealtime() - t_end < d) __builtin_amdgcn_s_sleep(8); }
#endif
#undef IN
#undef BOTH
#undef GRID_BAR
}

extern "C" void kernel_launch(void* const* d_in, const int* in_sizes, int n_in, void* d_out, int out_size, void* d_ws, size_t ws_size, hipStream_t stream) {
    static int grid = 0;
    if (grid == 0) {
        if (n_in != 23 || in_sizes[0] != M * DM || out_size != M * DM || ws_size < WS_END) { fprintf(stderr, "kernel_launch: unexpected shapes (n_in %d, in0 %d, out %d, ws %zu); nothing launched\n", n_in, n_in > 0 ? in_sizes[0] : -1, out_size, ws_size); grid = -1; return; }
        int dev = 0, cus = 0, per_cu = 0;
        if (hipGetDevice(&dev) != hipSuccess || hipDeviceGetAttribute(&cus, hipDeviceAttributeMultiprocessorCount, dev) != hipSuccess) { fprintf(stderr, "kernel_launch: device query failed\n"); grid = -1; return; }
        if (hipFuncSetAttribute((const void*)fwd_kernel, hipFuncAttributeMaxDynamicSharedMemorySize, LDS_BYTES) != hipSuccess) { fprintf(stderr, "kernel_launch: hipFuncSetAttribute failed\n"); grid = -1; return; }
        if (hipOccupancyMaxActiveBlocksPerMultiprocessor(&per_cu, (const void*)fwd_kernel, NWAVES * 64, LDS_BYTES) != hipSuccess || per_cu < 1) { fprintf(stderr, "kernel_launch: occupancy query reports %d workgroups per CU; nothing launched\n", per_cu); (void)hipGetLastError(); grid = -1; return; }
        grid = cus;
    }
    if (grid < 0) return;
    if (hipMemsetAsync((char*)d_ws + WS_CTL, 0, CTL_ZERO_BYTES, stream) != hipSuccess) { fprintf(stderr, "kernel_launch: hipMemsetAsync failed\n"); return; }
    Args a{};
    for (int i = 0; i < 23; ++i) a.in[i] = (const float*)d_in[i];
    a.out = (float*)d_out; a.ws = (unsigned char*)d_ws;
    for (int li = 0; li < N_LAUNCHES; ++li) {
        a.ph_lo = (N_LAUNCHES == PER_PHASE) ? li : 0; a.ph_hi = (N_LAUNCHES == PER_PHASE) ? li + 1 : PER_PHASE;
        hipLaunchKernelGGL(fwd_kernel, dim3(grid), dim3(NWAVES * 64), LDS_BYTES, stream, a);
        const hipError_t le = hipPeekAtLastError();
        if (le != hipSuccess) { fprintf(stderr, "kernel_launch: launch %d failed: %s\n", li, hipGetErrorName(le)); break; }
    }
}
```

```cpp
#include <hip/hip_runtime.h>
#include <cstdio>
#include <cstdint>
namespace pg8 {
#define PG8_LAS __attribute__((address_space(3)))
typedef unsigned short bf16_t;
typedef short bf16x8 __attribute__((ext_vector_type(8)));
typedef float f32x4 __attribute__((ext_vector_type(4)));
typedef unsigned u32x4 __attribute__((ext_vector_type(4)));
constexpr int BM = 256, BK = 64, HALF = 128, HTB = HALF * BK * 2  , STAGE_BYTES = 8 * HTB, NXCD = 8, WGM = 8;

__host__ __device__ __forceinline__ int lds_byte(int r, int c) { const int st = (r >> 4) * 2 + (c >> 5), rr = r & 15, cc = c & 31, ob = rr * 64 + cc * 2; return st * 1024 + (ob ^ (((ob >> 9) & 1) << 5)); }
__host__ __device__ __forceinline__ void stage_rc(int b, int& R, int& C) { const int st = b / 1024, sb = b % 1024, swz = sb ^ (((sb >> 9) & 1) << 5); R = (st >> 1) * 16 + swz / 64; C = (st & 1) * 32 + (swz % 64) / 2; }
__host__ __device__ __forceinline__ int perm32(int rho) { const int n = rho >> 4, i = rho & 15; return 8 * (i >> 2) + 4 * n + (i & 3); }

struct Unit { int pm, pn; };
struct Gemm { const bf16_t* A; const bf16_t* Bt; int M, N, K; };

struct StaticOrder {
    int nM, nN, nwg, G, c;
    __host__ __device__ void init(int M, int N, int G_, int c_) { nM = M / BM; nN = N / BM; nwg = nM * nN; G = G_; c = c_; }
    __host__ __device__ bool next(int i, Unit& u) const {
        const long L = (long)i * G + c; if (L >= nwg) return false;
        int wgid = (int)L; { const int q = nwg / NXCD, r = nwg % NXCD, xcd = wgid % NXCD, off = wgid / NXCD; wgid = (xcd < r ? xcd * (q + 1) : r * (q + 1) + (xcd - r) * q) + off; }
        const int nig = WGM * nN, gid = wgid / nig, fm = gid * WGM, gsz = (nM - fm) < WGM ? (nM - fm) : WGM;
        u.pm = fm + ((wgid % nig) % gsz); u.pn = (wgid % nig) / gsz; return true;
    }
    __device__ __forceinline__ void a_ready(const Unit&) const {}
    __device__ __forceinline__ void done(const Unit&) const {}
};

__device__ __forceinline__ unsigned cvt_pk_bf16(float lo, float hi) { unsigned r; asm volatile("v_cvt_pk_bf16_f32 %0, %1, %2" : "=v"(r) : "v"(lo), "v"(hi)); return r; }
typedef int i32x4 __attribute__((ext_vector_type(4)));
typedef int i32x8 __attribute__((ext_vector_type(8)));
__device__ __forceinline__ i32x8 pg8_cat(bf16x8 a, bf16x8 b) { const i32x4 x = __builtin_bit_cast(i32x4, a), y = __builtin_bit_cast(i32x4, b); return __builtin_shufflevector(x, y, 0, 1, 2, 3, 4, 5, 6, 7); }
__device__ __forceinline__ void pg8_mfma_f8(f32x4& c, const i32x8& a, const i32x8& b) { asm volatile("v_mfma_f32_16x16x128_f8f6f4 %0, %1, %2, %0" : "+v"(c) : "v"(a), "v"(b)); }
template <class Epi, class Sched, bool ALIGN_EPI = false, bool SP2 = false, bool FP8 = false, bool GATHER = false>
__device__ __forceinline__ void gemm_phase(PG8_LAS unsigned char* lds, const Gemm g, const Sched& S, const Epi& E) {
    const int tid = threadIdx.x, wid = __builtin_amdgcn_readfirstlane(tid >> 6), lane = tid & 63, wr = wid >> 2, wc = wid & 3, fr = lane & 15, fq = lane >> 4;
    const int K = g.K, nt = K / BK;
    unsigned voffA[2], voffB[2], rcR[2], rcC[2];
#pragma unroll
    for (int i = 0; i < 2; ++i) { int R, C; stage_rc(tid * 16 + i * 8192, R, C); const int Rb = Epi::PERM ? ((R & ~31) + perm32(R & 31)) : R;
        voffA[i] = (unsigned)(R * K + C) * 2u; voffB[i] = (unsigned)(Rb * K + C) * 2u; rcR[i] = (unsigned)R; rcC[i] = (unsigned)C * 2u; }
    const size_t kstep = (size_t)(BK * 2);
    const size_t hstep = (size_t)HALF * K * 2;
    const size_t tstep = 2 * hstep;
    unsigned gA[2][2], gN[2][2];
#define PG8_GOFF(dst, uidx) do { _Pragma("unroll") for (int h_ = 0; h_ < 2; ++h_) _Pragma("unroll") for (int i_ = 0; i_ < 2; ++i_) { \
        if constexpr (GATHER) dst[h_][i_] = (unsigned)S.arow((uidx), h_ * HALF + (int)rcR[i_]) * (unsigned)(K * 2) + rcC[i_]; else dst[h_][i_] = voffA[i_] + (unsigned)(h_ * hstep); } } while (0)
    const unsigned ldsw = (unsigned)wid * 1024u;
    const int aoff = lds_byte(wr * 64 + fr, fq * 8), boff = lds_byte(wc * 32 + fr, fq * 8);
#define PG8_SA(b, h) (((b) * 2 + (h)) * HTB)
#define PG8_SB(b, h) ((4 + (b) * 2 + (h)) * HTB)
#define PG8_STAGE(bufoff, gbase, voff) do { _Pragma("unroll") for (int _i = 0; _i < 2; ++_i) \
        __builtin_amdgcn_global_load_lds((const unsigned*)((const char*)(gbase) + (voff)[_i]), (PG8_LAS unsigned*)(lds + (bufoff) + ldsw + _i * 8192), 16, 0, 0); } while (0)
#define PG8_LDA(dst, b, h) do { if constexpr (FP8) { _Pragma("unroll") for (int m = 0; m < 4; ++m) dst##8[m] = pg8_cat(*(const PG8_LAS bf16x8*)(lds + PG8_SA(b, h) + aoff + m * 2048), *(const PG8_LAS bf16x8*)(lds + PG8_SA(b, h) + aoff + m * 2048 + 1024)); } else { \
        _Pragma("unroll") for (int m = 0; m < 4; ++m) _Pragma("unroll") for (int k = 0; k < 2; ++k) dst[m][k] = *(const PG8_LAS bf16x8*)(lds + PG8_SA(b, h) + aoff + m * 2048 + k * 1024); } } while (0)
#define PG8_LDB(dst, b, h) do { if constexpr (FP8) { _Pragma("unroll") for (int n = 0; n < 2; ++n) dst##8[n] = pg8_cat(*(const PG8_LAS bf16x8*)(lds + PG8_SB(b, h) + boff + n * 2048), *(const PG8_LAS bf16x8*)(lds + PG8_SB(b, h) + boff + n * 2048 + 1024)); } else { \
        _Pragma("unroll") for (int n = 0; n < 2; ++n) _Pragma("unroll") for (int k = 0; k < 2; ++k) dst[n][k] = *(const PG8_LAS bf16x8*)(lds + PG8_SB(b, h) + boff + n * 2048 + k * 1024); } } while (0)
#define PG8_MMA(ai, bj, At, Bt) do { __builtin_amdgcn_s_setprio(1); if constexpr (FP8) { _Pragma("unroll") for (int m = 0; m < 4; ++m) _Pragma("unroll") for (int n = 0; n < 2; ++n) \
        pg8_mfma_f8(acc[ai][bj][m][n], Bt##8[n], At##8[m]); } else { \
        _Pragma("unroll") for (int m = 0; m < 4; ++m) _Pragma("unroll") for (int n = 0; n < 2; ++n) _Pragma("unroll") for (int k = 0; k < 2; ++k) \
        acc[ai][bj][m][n] = __builtin_amdgcn_mfma_f32_16x16x32_bf16(Bt[n][k], At[m][k], acc[ai][bj][m][n], 0, 0, 0); } __builtin_amdgcn_s_setprio(0); } while (0)
#define PG8_WAIT_V(n) asm volatile("s_waitcnt vmcnt(" #n ")" ::: "memory")
#define PG8_WAIT_L(n) asm volatile("s_waitcnt lgkmcnt(" #n ")" ::: "memory")
#define PG8_BAR __builtin_amdgcn_s_barrier()
#define PG8_SCHED __builtin_amdgcn_sched_barrier(0)
    Unit cur, nxt; int ui = 0;
    if (!S.next(0, cur)) return;
    f32x4 acc[2][2][4][2];
#pragma unroll
    for (int a = 0; a < 2; ++a)
#pragma unroll
        for (int b = 0; b < 2; ++b)
#pragma unroll
            for (int m = 0; m < 4; ++m)
#pragma unroll
                for (int n = 0; n < 2; ++n) acc[a][b][m][n] = (f32x4){0.f, 0.f, 0.f, 0.f};
    bf16x8 At[4][2], B0[2][2], B1[2][2]; i32x8 At8[4], B08[2], B18[2];
    const char* cA = GATHER ? (const char*)g.A : (const char*)g.A + (size_t)cur.pm * tstep; const char* cB = (const char*)g.Bt + (size_t)(GATHER ? (cur.pn & 0xffff) : cur.pn) * tstep;
    PG8_GOFF(gA, 0); PG8_GOFF(gN, 0);
    S.a_ready(cur);
    if constexpr (SP2) {
        PG8_STAGE(PG8_SB(0, 0), cB, voffB); PG8_STAGE(PG8_SB(0, 1), cB + hstep, voffB); PG8_STAGE(PG8_SA(0, 0), cA, gA[0]); PG8_STAGE(PG8_SA(0, 1), cA, gA[1]);
        if (wr == 1) PG8_BAR;
        PG8_WAIT_V(2); PG8_BAR;
        PG8_STAGE(PG8_SB(1, 0), cB + kstep, voffB); PG8_STAGE(PG8_SA(1, 0), cA + kstep, gA[0]); PG8_STAGE(PG8_SB(1, 1), cB + hstep + kstep, voffB);
        PG8_WAIT_V(6); PG8_BAR;
    } else {
        PG8_STAGE(PG8_SB(0, 0), cB, voffB); PG8_STAGE(PG8_SA(0, 0), cA, gA[0]); PG8_STAGE(PG8_SB(0, 1), cB + hstep, voffB); PG8_STAGE(PG8_SA(0, 1), cA, gA[1]);
        if (wr == 1) PG8_BAR;
        PG8_WAIT_V(4); PG8_BAR;
        PG8_STAGE(PG8_SB(1, 0), cB + kstep, voffB); PG8_STAGE(PG8_SA(1, 0), cA + kstep, gA[0]); PG8_STAGE(PG8_SB(1, 1), cB + hstep + kstep, voffB);
        PG8_WAIT_V(6); PG8_BAR;
    }
    for (;;) {
        const bool has_next = S.next(ui + 1, nxt);
        const char* nA = (has_next && !GATHER) ? (const char*)g.A + (size_t)nxt.pm * tstep : cA; const char* nB = has_next ? (const char*)g.Bt + (size_t)(GATHER ? (nxt.pn & 0xffff) : nxt.pn) * tstep : cB;
        if constexpr (GATHER) { if (has_next) PG8_GOFF(gN, ui + 1); }
        _Pragma("nounroll") for (int t = 0; t < nt; t += 2) {
            const bool last = (t == nt - 2);
            const char* a1 = cA + (size_t)(t + 1) * kstep;
            const char* a2 = last ? nA : cA + (size_t)(t + 2) * kstep; const char* b2 = last ? nB : cB + (size_t)(t + 2) * kstep;
            const char* a3 = a2 + kstep; const char* b3 = b2 + kstep;
            unsigned g2[2][2];
#pragma unroll
            for (int h_ = 0; h_ < 2; ++h_)
#pragma unroll
                for (int i_ = 0; i_ < 2; ++i_) g2[h_][i_] = (GATHER && last) ? gN[h_][i_] : gA[h_][i_];
            if (last && has_next) S.a_ready(nxt);
            if constexpr (SP2) {
            PG8_LDB(B0, 0, 0); PG8_LDB(B1, 0, 1); PG8_SCHED; PG8_LDA(At, 0, 0); PG8_STAGE(PG8_SA(1, 1), a1, gA[1]);
            PG8_WAIT_V(8); PG8_WAIT_L(0); PG8_BAR; PG8_MMA(0, 0, At, B0); PG8_MMA(0, 1, At, B1); PG8_BAR; PG8_SCHED;
            PG8_LDA(At, 0, 1); PG8_STAGE(PG8_SB(0, 0), b2, voffB); PG8_STAGE(PG8_SB(0, 1), b2 + hstep, voffB); PG8_STAGE(PG8_SA(0, 0), a2, g2[0]);
            PG8_WAIT_V(8); PG8_WAIT_L(0); PG8_BAR; PG8_MMA(1, 0, At, B0); PG8_MMA(1, 1, At, B1); PG8_BAR; PG8_SCHED;
            PG8_LDB(B0, 1, 0); PG8_LDB(B1, 1, 1); PG8_SCHED; PG8_LDA(At, 1, 0); PG8_STAGE(PG8_SA(0, 1), a2, g2[1]);
            PG8_WAIT_V(8); PG8_WAIT_L(0); PG8_BAR; PG8_MMA(0, 0, At, B0); PG8_MMA(0, 1, At, B1); PG8_BAR; PG8_SCHED;
            PG8_LDA(At, 1, 1); PG8_STAGE(PG8_SB(1, 0), b3, voffB); PG8_STAGE(PG8_SB(1, 1), b3 + hstep, voffB); PG8_STAGE(PG8_SA(1, 0), a3, g2[0]);
            PG8_WAIT_V(8); PG8_WAIT_L(0); PG8_BAR; PG8_MMA(1, 0, At, B0); PG8_MMA(1, 1, At, B1); PG8_BAR; PG8_SCHED;
            } else {
            PG8_LDB(B0, 0, 0); PG8_SCHED; PG8_LDA(At, 0, 0); PG8_STAGE(PG8_SA(1, 1), a1, gA[1]);
            PG8_WAIT_L(8); PG8_BAR; PG8_WAIT_L(0); PG8_MMA(0, 0, At, B0); PG8_BAR; PG8_SCHED;
            PG8_LDB(B1, 0, 1); PG8_STAGE(PG8_SB(0, 0), b2, voffB);
            PG8_BAR; PG8_WAIT_L(0); PG8_MMA(0, 1, At, B1); PG8_BAR;
            PG8_LDA(At, 0, 1); PG8_STAGE(PG8_SA(0, 0), a2, g2[0]);
            PG8_BAR; PG8_WAIT_L(0); PG8_MMA(1, 0, At, B0); PG8_BAR; PG8_SCHED;
            PG8_STAGE(PG8_SB(0, 1), b2 + hstep, voffB);
            PG8_WAIT_V(6); PG8_BAR; PG8_MMA(1, 1, At, B1); PG8_BAR;
            PG8_LDB(B0, 1, 0); PG8_SCHED; PG8_LDA(At, 1, 0); PG8_STAGE(PG8_SA(0, 1), a2, g2[1]);
            PG8_WAIT_L(8); PG8_BAR; PG8_WAIT_L(0); PG8_MMA(0, 0, At, B0); PG8_BAR; PG8_SCHED;
            PG8_LDB(B1, 1, 1); PG8_STAGE(PG8_SB(1, 0), b3, voffB);
            PG8_BAR; PG8_WAIT_L(0); PG8_MMA(0, 1, At, B1); PG8_BAR;
            PG8_LDA(At, 1, 1); PG8_STAGE(PG8_SA(1, 0), a3, g2[0]);
            PG8_BAR; PG8_WAIT_L(0); PG8_MMA(1, 0, At, B0); PG8_BAR; PG8_SCHED;
            PG8_STAGE(PG8_SB(1, 1), b3 + hstep, voffB);
            PG8_WAIT_V(6); PG8_BAR; PG8_MMA(1, 1, At, B1); PG8_BAR;
            }
        }
        if constexpr (ALIGN_EPI) { if (wr == 0) PG8_BAR; }
        if constexpr (FP8) { asm volatile("s_nop 15\n\ts_nop 7" ::: "memory"); __builtin_amdgcn_sched_barrier(0); }
        if constexpr (!Epi::AFTER_DRAIN) { E(acc, cur, wr, wc, fr, fq); S.done(cur); }
        if (!has_next) break;
#pragma unroll
        for (int a = 0; a < 2; ++a)
#pragma unroll
            for (int b = 0; b < 2; ++b)
#pragma unroll
                for (int m = 0; m < 4; ++m)
#pragma unroll
                    for (int n = 0; n < 2; ++n) acc[a][b][m][n] = (f32x4){0.f, 0.f, 0.f, 0.f};
        cur = nxt; cA = nA; cB = nB; ++ui;
        if constexpr (GATHER) {
#pragma unroll
            for (int h_ = 0; h_ < 2; ++h_)
#pragma unroll
                for (int i_ = 0; i_ < 2; ++i_) gA[h_][i_] = gN[h_][i_]; }
        if constexpr (ALIGN_EPI) { if (wr == 1) PG8_BAR; }
    }
    PG8_WAIT_V(0);
    if constexpr (!ALIGN_EPI) { if (wr == 0) PG8_BAR; }
    PG8_BAR;
    if constexpr (Epi::AFTER_DRAIN) { E.fused(acc, cur, wr, wc, fr, fq, lds, wid, lane); S.done(cur); }
#undef PG8_SA
#undef PG8_GOFF
#undef PG8_SB
#undef PG8_STAGE
#undef PG8_LDA
#undef PG8_LDB
#undef PG8_MMA
#undef PG8_WAIT_V
#undef PG8_WAIT_L
#undef PG8_BAR
#undef PG8_SCHED
}
}
#define GAS __attribute__((address_space(1)))
#define LAS __attribute__((address_space(3)))
typedef unsigned short bf16;
typedef unsigned v4u __attribute__((ext_vector_type(4)));
typedef float f32x4 __attribute__((ext_vector_type(4)));
typedef short bf16x8 __attribute__((ext_vector_type(8)));
typedef GAS unsigned gu32;
typedef GAS unsigned long long gu64;
#define RLX_AGENT __ATOMIC_RELAXED, __HIP_MEMORY_SCOPE_AGENT
#define LDS_WAIT() asm volatile("s_waitcnt lgkmcnt(0)" ::: "memory")
#define VM_WAIT() asm volatile("s_waitcnt vmcnt(0)" ::: "memory")
__device__ __forceinline__ unsigned long long rt() { return __builtin_amdgcn_s_memrealtime(); }
__device__ __forceinline__ unsigned f2bf(float f) { unsigned u = __builtin_bit_cast(unsigned, f); return (u + 0x7fffu + ((u >> 16) & 1u)) >> 16; }
__device__ __forceinline__ unsigned pk2(float lo, float hi) { return f2bf(lo) | (f2bf(hi) << 16); }

#define XB_TMO      128
#define XB_XCNT(j)  (256  + 64 * (j))
#define XB_XSUB(j)  (1280 + 64 * (j))
#define XB_XGEN(j)  (2304 + 64 * (j))
#define XB_TOP      3328
#define XB_TOPGEN   3392
#define XCD_BAR_WORDS 3456
#define XB_SPIN_CAP (1u << 18)

__device__ __forceinline__ unsigned xb_ld(unsigned* p)              { return __hip_atomic_load(p, __ATOMIC_RELAXED, __HIP_MEMORY_SCOPE_AGENT); }
__device__ __forceinline__ unsigned xb_add(unsigned* p, unsigned v) { return __hip_atomic_fetch_add(p, v, __ATOMIC_RELAXED, __HIP_MEMORY_SCOPE_AGENT); }
__device__ __forceinline__ unsigned xb_xcc_id() { return (unsigned)__builtin_amdgcn_s_getreg((3 << 11) | 20) & 0xFu; }
#define XB_SPIN(cond, bar) do { unsigned _sp = 0; while (cond) { __builtin_amdgcn_s_sleep(1); \
    if ((++_sp & 255u) == 0u) { if (xb_ld(&(bar)[XB_TMO])) break; if (_sp > XB_SPIN_CAP) { atomicAdd(&(bar)[XB_TMO], 1u); break; } } } } while (0)

struct XcdBarrier {
    unsigned* bar; unsigned x;
    volatile LAS unsigned* st;
};

__device__ __forceinline__ XcdBarrier xcd_barrier_post(unsigned* bar, volatile LAS unsigned* st) {
    XcdBarrier b; b.bar = bar; b.x = xb_xcc_id(); b.st = st;
    if (threadIdx.x == 0) (void)xb_add(&bar[XB_XCNT(b.x)], 1u);
    return b;
}
__device__ __forceinline__ void xcd_barrier_complete(unsigned* bar, unsigned x, unsigned& nloc, unsigned& nx) {
    const unsigned G = gridDim.x * gridDim.y * gridDim.z;
    unsigned sum, cnt, mine, sp = 0u;
    for (;;) {
        sum = 0u; cnt = 0u; mine = 0u;
#pragma unroll
        for (unsigned j = 0; j < 16; ++j) { const unsigned c = xb_ld(&bar[XB_XCNT(j)]); sum += c; cnt += (c > 0u) ? 1u : 0u; mine = (j == x) ? c : mine; }
        if (sum == G) break;
        __builtin_amdgcn_s_sleep(1);
        if ((++sp & 255u) == 0u) { if (xb_ld(&bar[XB_TMO])) break; if (sp > XB_SPIN_CAP) { atomicAdd(&bar[XB_TMO], 1u); break; } }
    }
    nloc = mine > 0u ? mine : 1u; nx = cnt > 0u ? cnt : 1u;
}

__device__ __forceinline__ void xcd_barrier(const XcdBarrier& b) {
    asm volatile("s_waitcnt vmcnt(0)" ::: "memory");
    __syncthreads();
    if (threadIdx.x == 0) {
        unsigned* bar = b.bar;
        __builtin_amdgcn_s_waitcnt(0);
        unsigned nloc = b.st[0], nx = b.st[1];
        if (nloc == 0u) { xcd_barrier_complete(bar, b.x, nloc, nx); b.st[0] = nloc; b.st[1] = nx; }
        const unsigned old = xb_add(&bar[XB_XSUB(b.x)], 1u);
        const unsigned gen = old / nloc;
        if (old + 1u == (gen + 1u) * nloc) {
            __builtin_amdgcn_fence(__ATOMIC_RELEASE, "agent");
            asm volatile("s_waitcnt vmcnt(0)" ::: "memory");
            const unsigned og = xb_add(&bar[XB_TOP], 1u);
            const unsigned tg = og / nx;
            if (og + 1u == (tg + 1u) * nx) xb_add(&bar[XB_TOPGEN], 1u);
            else XB_SPIN(xb_ld(&bar[XB_TOPGEN]) == tg, bar);
            __builtin_amdgcn_fence(__ATOMIC_ACQUIRE, "agent");
            xb_add(&bar[XB_XGEN(b.x)], 1u);
            asm volatile("s_waitcnt vmcnt(0)" ::: "memory");
        } else {
            XB_SPIN(xb_ld(&bar[XB_XGEN(b.x)]) == gen, bar);
            __builtin_amdgcn_fence(__ATOMIC_ACQUIRE, "agent");
            asm volatile("s_waitcnt vmcnt(0)" ::: "memory");
        }
    }
    __syncthreads();
}


constexpr int NWAVES = 8;
#ifndef MK_N_LAUNCHES
#define MK_N_LAUNCHES 1
#endif
constexpr int PER_PHASE = 10;
constexpr int N_LAUNCHES = MK_N_LAUNCHES;

constexpr int BATCH = 4, SEQ = 4096, DM = 1024, M = BATCH * SEQ;
constexpr int DREC = 512, DATT = 512, NH = 8, HD = 64;
constexpr int NPROJ = 2560, LDW_IN = 2568;
constexpr int NE = 32, TOPK = 4;
constexpr int MAXSLOT = M * TOPK + NE * 256, MAXMT = MAXSLOT / 256;
constexpr int CHUNK = 64, NCHUNK = SEQ / CHUNK;
constexpr float EPS = 1e-6f;
constexpr float LOG2E = 1.4426950408889634f;
constexpr float QSCALE = 0.125f * LOG2E;

constexpr size_t MiB = 1u << 20;
constexpr size_t WS_CTL = 0, CTL_ZERO_BYTES = 1 * MiB;
constexpr size_t WS_WIN = 2 * MiB, WS_WOUT = 8 * MiB;
constexpr size_t WS_LOGF = 10 * MiB, WS_C2 = WS_LOGF + 512 * 1024, WS_AEND = 11 * MiB, WS_BEND = WS_AEND + 512 * 1024;
constexpr size_t WS_RSTD2 = 12 * MiB, WS_TKE = WS_RSTD2 + 256 * 1024, WS_TKP = WS_TKE + 256 * 1024, WS_TKG = WS_TKP + 256 * 1024, WS_SLOTG = 13 * MiB;
constexpr size_t WS_WGU = 16 * MiB, WS_WDN = 144 * MiB, WS_XN = 208 * MiB;
constexpr size_t WS_U = 240 * MiB, WS_GG = 256 * MiB, WS_Q = 272 * MiB, WS_K = 288 * MiB, WS_V = 304 * MiB, WS_ATT = 320 * MiB;
constexpr size_t WS_HLOC = 336 * MiB, WS_PC = 368 * MiB, WS_MIX = 400 * MiB, WS_XS = 576 * MiB, WS_HB = 648 * MiB, WS_END = 738 * MiB;
constexpr size_t WS_ATT1 = 720 * MiB, WS_L0 = 736 * MiB, WS_L1 = 737 * MiB;
constexpr size_t WS_XB = 208 * MiB;
constexpr size_t WS_LIST = 576 * MiB, WS_LISTG = 578 * MiB;
constexpr size_t WS_X1B = 240 * MiB;
constexpr size_t WS_YS = 432 * MiB;
constexpr int CW_TMO = 0, CW_BAR = 4096, CW_CNT = 16384;

constexpr int LDS_BYTES = 163840, LDSCTL_OFF = 155648;
constexpr int MISC_OFF = LDSCTL_OFF;
constexpr int TAB_OFF = LDSCTL_OFF + 256;


typedef float f32x16 __attribute__((ext_vector_type(16)));
typedef float f32x2 __attribute__((ext_vector_type(2)));
typedef unsigned u32x2 __attribute__((ext_vector_type(2)));
typedef short s16x4 __attribute__((ext_vector_type(4)));
typedef __bf16 bf16x2_t __attribute__((ext_vector_type(2)));
__device__ __forceinline__ unsigned cvtpk(float lo, float hi) { f32x2 v = {lo, hi}; bf16x2_t b = __builtin_convertvector(v, bf16x2_t); return __builtin_bit_cast(unsigned, b); }
__device__ __forceinline__ float bflo(unsigned w) { return __uint_as_float(w << 16); }
__device__ __forceinline__ float bfhi(unsigned w) { return __uint_as_float(w & 0xffff0000u); }
__device__ __forceinline__ float bf2f(bf16 h) { return __uint_as_float((unsigned)h << 16); }
__device__ __forceinline__ float wave_sum(float v) {
#pragma unroll
    for (int o = 1; o < 64; o <<= 1) v += __shfl_xor(v, o);
    return v;
}
__device__ __forceinline__ float wave_max(float v) {
#pragma unroll
    for (int o = 1; o < 64; o <<= 1) v = fmaxf(v, __shfl_xor(v, o));
    return v;
}
__device__ __forceinline__ float fast_exp(float x) { return __builtin_amdgcn_exp2f(x * LOG2E); }
__device__ __forceinline__ float fast_sigmoid(float x) { return __builtin_amdgcn_rcpf(1.0f + fast_exp(-x)); }
__device__ __forceinline__ float gelu_tanh(float x) {
    const float y = 0.7978845608028654f * (x + 0.044715f * x * x * x);
    const float t = 1.0f - 2.0f * __builtin_amdgcn_rcpf(1.0f + fast_exp(2.0f * y));
    return 0.5f * x * (1.0f + t);
}
__device__ __forceinline__ f32x4 gelu_tanh4(f32x4 x) {
    const f32x4 t = (x * x) * 0.044715f + 1.0f;
    f32x4 e = (x * (-1.5957691216f * LOG2E)) * t;
#pragma unroll
    for (int j = 0; j < 4; ++j) e[j] = __builtin_amdgcn_exp2f(e[j]);
    f32x4 d = e + 1.0f;
#pragma unroll
    for (int j = 0; j < 4; ++j) d[j] = __builtin_amdgcn_rcpf(d[j]);
    return x * d;
}
__device__ __forceinline__ int crow(int r, int hi) { return (r & 3) + 8 * (r >> 2) + 4 * hi; }

struct Ctx {
    LAS unsigned char* lds;
    int tid, lane, wave, vcu, G;
    const float* in[23];
    float* out;
    unsigned char* ws;
};
#define WSP(T, off) ((T*)(C.ws + (off)))

struct P0It { const float* src; unsigned char* dst; int ldw; int fp8; };
__device__ __forceinline__ int win_src_col(int n_dst) {
    const int pn = n_dst >> 8, c = n_dst & 255;
    if (pn < 4 || pn >= 8) return n_dst;
    const int base = 1024 + (pn - 4) * 256;
    return base + ((c >> 5) & 3) * 64 + (c >> 7) * 32 + (c & 31);
}
constexpr int P0_I_IN = 16 * 80, P0_I_OUT = 16 * 32, P0_NITEMS = P0_I_IN + P0_I_OUT;
__device__ __forceinline__ P0It p0_decode(const Ctx& C, int it) {
    P0It r; int q = it;
    if (q < P0_I_IN) { const int kb = q / 80, nb = q % 80;
        r.src = C.in[2] + (size_t)(kb * 64) * LDW_IN + win_src_col(nb * 32); r.ldw = LDW_IN; r.fp8 = 0;
        r.dst = C.ws + WS_WIN + ((size_t)(nb * 32) * DM + kb * 64) * 2; return r; } q -= P0_I_IN;
    { const int kb = q >> 5, nb = q & 31;
        r.src = C.in[15] + (size_t)(kb * 64) * DM + nb * 32; r.ldw = DM; r.fp8 = 0;
        r.dst = C.ws + WS_WOUT + ((size_t)(nb * 32) * DM + kb * 64) * 2; return r; }
}
__device__ __forceinline__ void p0_load(const P0It& I, f32x4 (&v)[8], int lane) {
#pragma unroll
    for (int i = 0; i < 8; ++i) v[i] = *(const f32x4*)(I.src + (size_t)(i * 8 + (lane >> 3)) * I.ldw + (lane & 7) * 4);
}
__device__ __forceinline__ unsigned pk_fp8x4(float a, float b, float c, float d) { int w = __builtin_amdgcn_cvt_pk_fp8_f32(a, b, 0, false); w = __builtin_amdgcn_cvt_pk_fp8_f32(c, d, w, true); return (unsigned)w; }
__device__ __forceinline__ void p0_store(const P0It& I, const f32x4 (&v)[8], LAS float* scr, int lane) {
#pragma unroll
    for (int i = 0; i < 8; ++i) { LAS float* s = scr + (i * 8 + (lane >> 3)) * 33 + (lane & 7) * 4; s[0] = v[i].x; s[1] = v[i].y; s[2] = v[i].z; s[3] = v[i].w; }
    LDS_WAIT(); asm volatile("" ::: "memory");
    const int n = lane & 31;
    if (I.fp8) {
#pragma unroll
        for (int jj = 0; jj < 2; ++jj) { const int kc = (lane >> 5) + 2 * jj; const LAS float* s = scr + (16 * kc) * 33 + n;
            v4u o; o.x = pk_fp8x4(s[0] * 32.f, s[33] * 32.f, s[66] * 32.f, s[99] * 32.f); o.y = pk_fp8x4(s[132] * 32.f, s[165] * 32.f, s[198] * 32.f, s[231] * 32.f);
            o.z = pk_fp8x4(s[264] * 32.f, s[297] * 32.f, s[330] * 32.f, s[363] * 32.f); o.w = pk_fp8x4(s[396] * 32.f, s[429] * 32.f, s[462] * 32.f, s[495] * 32.f);
            *(v4u*)(I.dst + (size_t)n * 1024 + 16 * kc) = o; }
    } else {
#pragma unroll
        for (int jj = 0; jj < 4; ++jj) { const int kc = (lane >> 5) + 2 * jj; const LAS float* s = scr + (8 * kc) * 33 + n;
            v4u o; o.x = cvtpk(s[0], s[33]); o.y = cvtpk(s[66], s[99]); o.z = cvtpk(s[132], s[165]); o.w = cvtpk(s[198], s[231]);
            *(v4u*)(I.dst + (size_t)n * 2048 + 16 * kc) = o; }
    }
    LDS_WAIT(); asm volatile("" ::: "memory");
}
__device__ __forceinline__ void p0_prologue(const Ctx& C) {
    LAS float* scr = (LAS float*)(C.lds + C.wave * 8448);
    LAS float* wfT = (LAS float*)(C.lds + 69632);
    const float* w_in = C.in[2];
    const int gw = C.vcu * NWAVES + C.wave, NGW = C.G * NWAVES;
    const float* x = C.in[0]; const float* ln1 = C.in[1]; const float* bfg = C.in[10];
    f32x4 w[4], v[4], vn[4], vnn[4];
    { const int m1 = (gw + NGW < M) ? gw + NGW : gw;
#pragma unroll
      for (int jj = 0; jj < 4; ++jj) { v[jj] = ((const f32x4*)(x + (size_t)gw * DM) + C.lane)[64 * jj]; vn[jj] = ((const f32x4*)(x + (size_t)m1 * DM) + C.lane)[64 * jj]; vnn[jj] = vn[jj]; } }
    f32x4 va[8];
    int it = gw < P0_NITEMS ? gw : P0_NITEMS - 1;
    P0It ia = p0_decode(C, it);
    p0_load(ia, va, C.lane);
    { float wv_[16], lv_[16];
#pragma unroll
      for (int i = 0; i < 16; ++i) { const int idx = C.tid + i * NWAVES * 64, d = idx >> 3; wv_[i] = w_in[(size_t)d * LDW_IN + NPROJ + (idx & 7)]; lv_[i] = C.in[1][d]; }
#pragma unroll
      for (int i = 0; i < 16; ++i) { const int idx = C.tid + i * NWAVES * 64; wfT[(idx & 7) * 1024 + (idx >> 3)] = wv_[i] * lv_[i]; } }
#pragma unroll
    for (int jj = 0; jj < 4; ++jj) w[jj] = *(const f32x4*)(ln1 + 4 * C.lane + 256 * jj);
    __syncthreads();
    {
        bf16* XN = WSP(bf16, WS_XN); float* LOGF = WSP(float, WS_LOGF);
        for (int m = gw; m < M; m += NGW) {
            { const int mn = (m + 2 * NGW < M) ? m + 2 * NGW : m;
#pragma unroll
              for (int jj = 0; jj < 4; ++jj) vnn[jj] = ((const f32x4*)(x + (size_t)mn * DM) + C.lane)[64 * jj]; }
            float ss = 0.f, f[8];
#pragma unroll
            for (int jj = 0; jj < 4; ++jj) ss += (v[jj].x * v[jj].x + v[jj].y * v[jj].y) + (v[jj].z * v[jj].z + v[jj].w * v[jj].w);
#pragma unroll
            for (int j = 0; j < 8; ++j) { float a = 0.f;
#pragma unroll
                for (int jj = 0; jj < 4; ++jj) { const f32x4 wv = *(const LAS f32x4*)(wfT + j * 1024 + 4 * C.lane + 256 * jj); a += (v[jj].x * wv.x + v[jj].y * wv.y) + (v[jj].z * wv.z + v[jj].w * wv.w); }
                f[j] = a; if ((j & 3) == 3) __builtin_amdgcn_sched_barrier(0); }
#pragma unroll
            for (int o = 1; o < 64; o <<= 1) {
                ss += __shfl_xor(ss, o);
#pragma unroll
                for (int j = 0; j < 8; ++j) f[j] += __shfl_xor(f[j], o); }
            const float rstd = 1.0f / sqrtf(ss * (1.0f / DM) + EPS);
#pragma unroll
            for (int j = 0; j < 8; ++j) f[j] *= rstd;
#pragma unroll
            for (int jj = 0; jj < 4; ++jj) v[jj] = v[jj] * rstd * w[jj];
            unsigned long long* o8 = (unsigned long long*)(XN + (size_t)m * DM) + C.lane;
#pragma unroll
            for (int jj = 0; jj < 4; ++jj) o8[64 * jj] = (unsigned long long)cvtpk(v[jj].x, v[jj].y) | ((unsigned long long)cvtpk(v[jj].z, v[jj].w) << 32);
            float z = f[0];
#pragma unroll
            for (int j = 1; j < 8; ++j) z = (C.lane == j) ? f[j] : z;
            if (C.lane < 8) { z += bfg[C.lane]; const float ls = fminf(z, 0.f) - log1pf(expf(-fabsf(z))); const int b = m >> 12, t = m & 4095; LOGF[(size_t)(b * NH + C.lane) * SEQ + t] = ls; }
#pragma unroll
            for (int jj = 0; jj < 4; ++jj) { v[jj] = vn[jj]; vn[jj] = vnn[jj]; }
        }
    }
    if (gw < P0_NITEMS) {
        p0_store(ia, va, scr, C.lane);
        for (it += NGW; it < P0_NITEMS; it += NGW) { ia = p0_decode(C, it); p0_load(ia, va, C.lane); p0_store(ia, va, scr, C.lane); }
    }
}

__device__ __forceinline__ void p1_cumsum(const Ctx& C) {
    if ((int)blockIdx.x >= (int)gridDim.x - BATCH * NH) {
        const int bh = (int)blockIdx.x - ((int)gridDim.x - BATCH * NH); const float* src = WSP(float, WS_LOGF) + (size_t)bh * SEQ + 8 * C.tid; float* dst = WSP(float, WS_C2) + (size_t)bh * SEQ + 8 * C.tid;
        LAS float* wtot = (LAS float*)C.lds;
        const f32x4 a = *(const f32x4*)src, b = *(const f32x4*)(src + 4);
        float v[8] = {a.x, a.y, a.z, a.w, b.x, b.y, b.z, b.w};
#pragma unroll
        for (int e = 1; e < 8; ++e) v[e] += v[e - 1];
        const float run = v[7]; float s = run;
#pragma unroll
        for (int o = 1; o < 64; o <<= 1) { const float t = __shfl_up(s, o); if (C.lane >= o) s += t; }
        if (C.lane == 63) wtot[C.wave] = s;
        __syncthreads();
        float base = 0.f;
        for (int w = 0; w < C.wave; ++w) base += wtot[w];
        const float excl = base + s - run;
        f32x4 o0 = {(excl + v[0]) * LOG2E, (excl + v[1]) * LOG2E, (excl + v[2]) * LOG2E, (excl + v[3]) * LOG2E};
        f32x4 o1 = {(excl + v[4]) * LOG2E, (excl + v[5]) * LOG2E, (excl + v[6]) * LOG2E, (excl + v[7]) * LOG2E};
        *(f32x4*)dst = o0; *(f32x4*)(dst + 4) = o1;
        __syncthreads();
    }
}
struct EpiInProj {
    static constexpr bool PERM = true, AFTER_DRAIN = false;
    bf16 *U; const float *qw, *kw;
    __device__ __forceinline__ void operator()(const pg8::f32x4 (&acc)[2][2][4][2], const pg8::Unit& u, int wr, int wc, int fr, int fq) const {
        const int pn = u.pn, row0 = u.pm * 256 + wr * 64 + fr;
        if (pn < 4 || pn >= 8) {
            bf16* base = U + (size_t)(pn >> 1) * (size_t)(8u << 20); const bool act = (pn == 2 || pn == 3);
            const int col0 = (pn & 1) * 256 + wc * 32 + 8 * fq;
#pragma unroll
            for (int ai = 0; ai < 2; ++ai)
#pragma unroll
                for (int m = 0; m < 4; ++m) { bf16* rowp = base + (size_t)(row0 + ai * 128 + m * 16) * 512 + col0;
#pragma unroll
                    for (int bj = 0; bj < 2; ++bj) { pg8::f32x4 v0 = acc[ai][bj][m][0], v1 = acc[ai][bj][m][1];
                        if (act) { v0 = gelu_tanh4(v0); v1 = gelu_tanh4(v1); }
                        *(v4u*)(rowp + bj * 128) = (v4u){cvtpk(v0[0], v0[1]), cvtpk(v0[2], v0[3]), cvtpk(v1[0], v1[1]), cvtpk(v1[2], v1[3])}; } }
        } else {
            const bool isq = pn < 6; bf16* base = U + (size_t)(pn >> 1) * (size_t)(8u << 20); const float* wp = isq ? qw : kw; const float sc = isq ? QSCALE : 1.0f;
            const int head = (pn & 1) * 4 + wc;
            pg8::f32x4 wv[2][2];
#pragma unroll
            for (int bj = 0; bj < 2; ++bj)
#pragma unroll
                for (int n = 0; n < 2; ++n) wv[bj][n] = *(const pg8::f32x4*)(wp + 32 * bj + 8 * fq + 4 * n) * sc;
#pragma unroll
            for (int ai = 0; ai < 2; ++ai)
#pragma unroll
                for (int m = 0; m < 4; ++m) {
                    float ss = 0.f;
#pragma unroll
                    for (int bj = 0; bj < 2; ++bj)
#pragma unroll
                        for (int n = 0; n < 2; ++n) { const pg8::f32x4 v = acc[ai][bj][m][n]; ss += (v[0] * v[0] + v[1] * v[1]) + (v[2] * v[2] + v[3] * v[3]); }
                    ss += __shfl_xor(ss, 16); ss += __shfl_xor(ss, 32);
                    const float rstd = 1.0f / sqrtf(ss * (1.0f / HD) + EPS);
                    bf16* rowp = base + (size_t)(row0 + ai * 128 + m * 16) * 512 + head * 64 + 8 * fq;
#pragma unroll
                    for (int bj = 0; bj < 2; ++bj) { const pg8::f32x4 v0 = acc[ai][bj][m][0] * rstd * wv[bj][0], v1 = acc[ai][bj][m][1] * rstd * wv[bj][1];
                        *(v4u*)(rowp + 32 * bj) = (v4u){cvtpk(v0[0], v0[1]), cvtpk(v0[2], v0[3]), cvtpk(v1[0], v1[1]), cvtpk(v1[2], v1[3])}; } }
        }
    }
};

__device__ __forceinline__ void lru_pass1(const Ctx& C, int unit) {
    const int b = unit >> 6, ch = unit & 63, row0 = b * SEQ + ch * CHUNK, g = C.wave, lane = C.lane, j32 = lane & 31, hi = lane >> 5;
    const bf16* U = WSP(bf16, WS_U);
    unsigned* HP = WSP(unsigned, WS_HLOC);
    LAS float* XC = (LAS float*)C.lds + C.wave * (64 * 68);
    {
        const int c = 64 * g + lane; const float* conv_w = C.in[3];
        const float cw0 = conv_w[c], cw1 = conv_w[512 + c], cw2 = conv_w[1024 + c], cw3 = conv_w[1536 + c], cb = C.in[4][c];
        float um3 = 0.f, um2 = 0.f, um1 = 0.f;
        if (ch > 0) { um3 = bf2f(U[(size_t)(row0 - 3) * 512 + c]); um2 = bf2f(U[(size_t)(row0 - 2) * 512 + c]); um1 = bf2f(U[(size_t)(row0 - 1) * 512 + c]); }
#pragma unroll 1
        for (int t0_ = 0; t0_ < CHUNK; t0_ += 32) {
            float ut[32];
#pragma unroll
            for (int tt = 0; tt < 32; ++tt) ut[tt] = bf2f(U[(size_t)(row0 + t0_ + tt) * 512 + c]);
#pragma unroll
            for (int tt = 0; tt < 32; ++tt) {
                XC[(t0_ + tt) * 68 + lane] = cb + cw0 * um3 + cw1 * um2 + cw2 * um1 + cw3 * ut[tt];
                um3 = um2; um2 = um1; um1 = ut[tt];
            }
        }
    }
    LDS_WAIT(); asm volatile("" ::: "memory");
    bf16x8 xa[2][4];
#pragma unroll
    for (int tb = 0; tb < 2; ++tb)
#pragma unroll
        for (int ks = 0; ks < 4; ++ks) { const LAS float* p = XC + (32 * tb + j32) * 68 + 16 * ks + 8 * hi; const f32x4 lo = *(const LAS f32x4*)p, h4 = *(const LAS f32x4*)(p + 4);
            const v4u ux = {cvtpk(lo.x, lo.y), cvtpk(lo.z, lo.w), cvtpk(h4.x, h4.y), cvtpk(h4.z, h4.w)}; xa[tb][ks] = __builtin_bit_cast(bf16x8, ux); }
#pragma unroll 1
    for (int jb = 0; jb < 2; ++jb) {
        const int c = 64 * g + 32 * jb + j32;
        const float ba = C.in[6][c], bi = C.in[8][c], lam = C.in[9][c];
        const float sp8 = 8.0f * (fmaxf(-lam, 0.f) + log1pf(expf(-fabsf(lam))));
        float Cin = 0.f, Pin = 1.f;
        bf16x8 wa[4], wi[4];
#pragma unroll
        for (int ks = 0; ks < 4; ++ks) {
            const float* pa = C.in[5] + (size_t)(g * 64 + 16 * ks + 8 * hi) * 64 + 32 * jb + j32; const float* pi = C.in[7] + (size_t)(g * 64 + 16 * ks + 8 * hi) * 64 + 32 * jb + j32;
            const v4u ua = {cvtpk(pa[0], pa[64]), cvtpk(pa[128], pa[192]), cvtpk(pa[256], pa[320]), cvtpk(pa[384], pa[448])};
            const v4u ui = {cvtpk(pi[0], pi[64]), cvtpk(pi[128], pi[192]), cvtpk(pi[256], pi[320]), cvtpk(pi[384], pi[448])};
            wa[ks] = __builtin_bit_cast(bf16x8, ua); wi[ks] = __builtin_bit_cast(bf16x8, ui);
        }
#pragma unroll
        for (int tb = 0; tb < 2; ++tb) {
            f32x16 ra = {}, ri = {};
#pragma unroll
            for (int ks = 0; ks < 4; ++ks) {
                ra = __builtin_amdgcn_mfma_f32_32x32x16_bf16(xa[tb][ks], wa[ks], ra, 0, 0, 0); ri = __builtin_amdgcn_mfma_f32_32x32x16_bf16(xa[tb][ks], wi[ks], ri, 0, 0, 0); }
            float hl[16], pl[16], Ao[4], Bo[4], Ap[4], Bp[4], cin[4], pin[4];
#pragma unroll
            for (int r = 0; r < 16; ++r) {
                const float xo = XC[(32 * tb + crow(r, hi)) * 68 + 32 * jb + j32];
                const float rr = fast_sigmoid(ra[r] + ba), ig = fast_sigmoid(ri[r] + bi);
                const float a = fast_exp(-sp8 * rr);
                const float bb = sqrtf(fmaxf(1.0f - a * a, 0.f)) * ig * xo;
                if ((r & 3) == 0) { hl[r] = bb; pl[r] = a; } else { hl[r] = a * hl[r - 1] + bb; pl[r] = pl[r - 1] * a; }
            }
#pragma unroll
            for (int rg = 0; rg < 4; ++rg) { Ao[rg] = pl[4 * rg + 3]; Bo[rg] = hl[4 * rg + 3]; Ap[rg] = __shfl_xor(Ao[rg], 32); Bp[rg] = __shfl_xor(Bo[rg], 32); }
#pragma unroll
            for (int rg = 0; rg < 4; ++rg)
#pragma unroll
                for (int half = 0; half < 2; ++half) {
                    const bool own = (half == hi); const float As = own ? Ao[rg] : Ap[rg], Bs = own ? Bo[rg] : Bp[rg];
                    if (half == 0) { cin[rg] = Cin; pin[rg] = Pin; } else { cin[rg] = own ? Cin : cin[rg]; pin[rg] = own ? Pin : pin[rg]; }
                    Cin = As * Cin + Bs; Pin = Pin * As;
                }
#pragma unroll
            for (int r = 0; r < 16; ++r) { const size_t off = (size_t)(row0 + 32 * tb + crow(r, hi)) * 512 + c;
                HP[off] = cvtpk(hl[r] + pl[r] * cin[r >> 2], pl[r] * pin[r >> 2]); }
        }
        if (hi == 0) { WSP(float, WS_AEND)[(size_t)(b * NCHUNK + ch) * 512 + c] = Pin; WSP(float, WS_BEND)[(size_t)(b * NCHUNK + ch) * 512 + c] = Cin; }
    }
    __syncthreads();
}

__device__ __forceinline__ s16x4 vtr(const LAS unsigned char* p) { typedef short v4i16_t __attribute__((ext_vector_type(4))); return __builtin_bit_cast(s16x4, __builtin_amdgcn_ds_read_tr16_b64_v4i16((LAS v4i16_t*)p)); }
constexpr int ATT_SLOT = 18432;
constexpr int ATT_RING = 4 * ATT_SLOT, CV_SCR_OFF = ATT_RING, P2_LIST_OFF = CV_SCR_OFF + 8 * 8448, P2_MISC_OFF = P2_LIST_OFF + 4096;
constexpr float SKIP_T = 40.0f;
constexpr int CV_COST = 4;
constexpr int CW_QUEUE = 20480, CW_QUEUE2 = 24576;
constexpr int NCV_ALL = 4 * (512 + 256), NCV_P1 = 3 * 128, NCV_P7 = 256, NCV = NCV_ALL - NCV_P1 - NCV_P7, CW_DEFER = 28672;
__device__ __forceinline__ void glds16(const void* gsrc, unsigned lds_dst) { unsigned keep;
    asm volatile("s_mov_b32 %0, m0\n\ts_mov_b32 m0, %2\n\ts_nop 0\n\tglobal_load_lds_dwordx4 %1, off\n\ts_mov_b32 m0, %0" : "=&s"(keep) : "v"(gsrc), "s"(lds_dst) : "memory"); }
__device__ __forceinline__ void glds4(const void* gsrc, unsigned lds_dst) { unsigned keep;
    asm volatile("s_mov_b32 %0, m0\n\ts_mov_b32 m0, %2\n\ts_nop 0\n\tglobal_load_lds_dword %1, off\n\ts_mov_b32 m0, %0" : "=&s"(keep) : "v"(gsrc), "s"(lds_dst) : "memory"); }
__device__ __forceinline__ void attn_dma(const bf16* ksrc, const bf16* vsrc, const float* csrc, LAS unsigned char* lds, int slot, int wave) {
    const unsigned base = (unsigned)(uintptr_t)lds + (unsigned)(slot * ATT_SLOT);
    glds16(ksrc, (unsigned)__builtin_amdgcn_readfirstlane((int)(base + wave * 1024)));
    glds16(vsrc, (unsigned)__builtin_amdgcn_readfirstlane((int)(base + 8192 + wave * 1024)));
    glds4(csrc, (unsigned)__builtin_amdgcn_readfirstlane((int)(base + 16384 + wave * 256)));
}
__device__ __forceinline__ void attn_item(const Ctx& C, unsigned item, float sref) {
    const int lane = C.lane, wave = C.wave, r32 = lane & 31, hi = lane >> 5;
    const int u = item & 511, part = (item >> 9) & 1, split = (item >> 10) & 1, t0 = (item >> 11) & 127, t1 = (item >> 18) & 127;
    const int b = u >> 7, h = (u >> 4) & 7, qb = u & 15;
    const bf16* Qg = WSP(bf16, WS_Q); const bf16* Kg = WSP(bf16, WS_K); const bf16* Vg = WSP(bf16, WS_V);
    const float* c2 = WSP(float, WS_C2) + (size_t)(b * NH + h) * SEQ;
    const int q0 = qb * 256, rowbase = b * SEQ, qg = q0 + wave * 32 + r32;
    bf16x8 qf[4];
    { const bf16* qp = Qg + (size_t)(rowbase + qg) * 512 + h * 64 + 8 * hi;
#pragma unroll
      for (int ds = 0; ds < 4; ++ds) qf[ds] = *(const bf16x8*)(qp + 16 * ds); }
    const float cinit = c2[qg] - sref;
    const bf16* ksrc = Kg + (size_t)(rowbase + 8 * wave + (lane >> 3)) * 512 + h * 64 + (((lane & 7) ^ (lane >> 3)) << 3);
    const bf16* vsrc = Vg + (size_t)(rowbase + 8 * wave + (lane >> 3)) * 512 + h * 64 + ((lane & 7) << 3);
    const float* csrc = c2 + lane;
    asm volatile("" :: "v"(cinit), "v"(qf[0]), "v"(qf[1]), "v"(qf[2]), "v"(qf[3]));
    asm volatile("s_waitcnt vmcnt(0)" ::: "memory");
#pragma unroll
    for (int i = 0; i < 2; ++i) { const int tl = (t0 + i < t1) ? t0 + i : t1 - 1; attn_dma(ksrc + (size_t)tl * 64 * 512, vsrc + (size_t)tl * 64 * 512, csrc + tl * 64, C.lds, i, wave); }
    float lrun = 0.f; f32x16 o0 = {}, o1 = {};
    const int qfirst = q0 + wave * 32;
    const int kra = r32 * 128;
    const int i16 = lane & 15, g4 = lane >> 4;
    const int vra = (4 * hi + (i16 >> 2)) * 128 + (16 * (g4 & 1) + 4 * (i16 & 3)) * 2;
    f32x16 pa0, pa1;
#define ATT_WAIT_ISSUE(tt_) { \
        asm volatile("s_waitcnt vmcnt(3)" ::: "memory");                     \
        __builtin_amdgcn_s_barrier();                                        \
        asm volatile("" ::: "memory"); \
        { const int tl = ((tt_) + 2 < t1) ? (tt_) + 2 : t1 - 1; attn_dma(ksrc + (size_t)tl * 64 * 512, vsrc + (size_t)tl * 64 * 512, csrc + tl * 64, C.lds, ((tt_) - t0 + 2) & 3, wave); } }
#define ATT_QK(slot_, c0_, c1_) { \
        const LAS unsigned char* Kc = C.lds + (slot_) * ATT_SLOT; const LAS float* CKc = (const LAS float*)(Kc + 16384 + wave * 256); \
        _Pragma("unroll") for (int r = 0; r < 16; ++r) { c0_[r] = cinit; c1_[r] = cinit; } \
        _Pragma("unroll") for (int ds = 0; ds < 4; ++ds) { const int chs = ((2 * ds + hi) ^ (r32 & 7)) << 4; \
            const bf16x8 ka = *(const LAS bf16x8*)(Kc + kra + chs), kb = *(const LAS bf16x8*)(Kc + 4096 + kra + chs); \
            c0_ = __builtin_amdgcn_mfma_f32_32x32x16_bf16(ka, qf[ds], c0_, 0, 0, 0); c1_ = __builtin_amdgcn_mfma_f32_32x32x16_bf16(kb, qf[ds], c1_, 0, 0, 0); } \
        _Pragma("unroll") for (int g = 0; g < 4; ++g) { const f32x4 ca = *(const LAS f32x4*)(CKc + 8 * g + 4 * hi), cb = *(const LAS f32x4*)(CKc + 32 + 8 * g + 4 * hi); \
            c0_[4 * g] -= ca.x; c0_[4 * g + 1] -= ca.y; c0_[4 * g + 2] -= ca.z; c0_[4 * g + 3] -= ca.w; c1_[4 * g] -= cb.x; c1_[4 * g + 1] -= cb.y; c1_[4 * g + 2] -= cb.z; c1_[4 * g + 3] -= cb.w; } }
#define ATT_MASK(tt_, c0_, c1_) { const int k0 = (tt_) * 64; if (k0 + 63 > qfirst) { asm volatile("; diagonal tile: mask" ::: "memory");     \
        _Pragma("unroll") for (int r = 0; r < 16; ++r) { const int kv = k0 + crow(r, hi); if (kv > qg) c0_[r] = -INFINITY; if (kv + 32 > qg) c1_[r] = -INFINITY; } } }
#define ATT_SMPV(slot_, p0_, p1_) { \
        const LAS unsigned char* Vc = C.lds + (slot_) * ATT_SLOT + 8192; float ls = 0.f; \
        _Pragma("unroll") for (int r = 0; r < 16; ++r) { p0_[r] = __builtin_amdgcn_exp2f(p0_[r]); p1_[r] = __builtin_amdgcn_exp2f(p1_[r]); ls += p0_[r] + p1_[r]; } \
        lrun += ls; \
        v4u pw[4]; \
        pw[0] = (v4u){cvtpk(p0_[0], p0_[1]), cvtpk(p0_[2], p0_[3]), cvtpk(p0_[4], p0_[5]), cvtpk(p0_[6], p0_[7])}; \
        pw[1] = (v4u){cvtpk(p0_[8], p0_[9]), cvtpk(p0_[10], p0_[11]), cvtpk(p0_[12], p0_[13]), cvtpk(p0_[14], p0_[15])}; \
        pw[2] = (v4u){cvtpk(p1_[0], p1_[1]), cvtpk(p1_[2], p1_[3]), cvtpk(p1_[4], p1_[5]), cvtpk(p1_[6], p1_[7])}; \
        pw[3] = (v4u){cvtpk(p1_[8], p1_[9]), cvtpk(p1_[10], p1_[11]), cvtpk(p1_[12], p1_[13]), cvtpk(p1_[14], p1_[15])}; \
        _Pragma("unroll") for (int ks = 0; ks < 4; ++ks) { const LAS unsigned char* vb = Vc + vra + ks * 16 * 128; \
            const s16x4 a0 = vtr(vb), a1 = vtr(vb + 8 * 128), b0 = vtr(vb + 64), b1 = vtr(vb + 8 * 128 + 64); \
            const bf16x8 va = {a0[0], a0[1], a0[2], a0[3], a1[0], a1[1], a1[2], a1[3]}, vbb = {b0[0], b0[1], b0[2], b0[3], b1[0], b1[1], b1[2], b1[3]}; \
            const bf16x8 pf = __builtin_bit_cast(bf16x8, pw[ks]); \
            o0 = __builtin_amdgcn_mfma_f32_32x32x16_bf16(va, pf, o0, 0, 0, 0); o1 = __builtin_amdgcn_mfma_f32_32x32x16_bf16(vbb, pf, o1, 0, 0, 0); } }
    ATT_WAIT_ISSUE(t0);
    ATT_QK(0, pa0, pa1);
    ATT_MASK(t0, pa0, pa1);
    for (int tt = t0 + 1; tt < t1; ++tt) {
        const int slot = (tt - t0) & 3, pslot = (tt - t0 - 1) & 3;
        ATT_WAIT_ISSUE(tt);
        f32x16 c0, c1;
        ATT_QK(slot, c0, c1);
        ATT_SMPV(pslot, pa0, pa1);
        ATT_MASK(tt, c0, c1);
        pa0 = c0; pa1 = c1;
    }
    { const int pslot = (t1 - 1 - t0) & 3; ATT_SMPV(pslot, pa0, pa1); }
#undef ATT_WAIT_ISSUE
#undef ATT_QK
#undef ATT_MASK
#undef ATT_SMPV
    { auto rr = __builtin_amdgcn_permlane32_swap(__float_as_uint(lrun), __float_as_uint(lrun), false, false); lrun = __uint_as_float(rr[0]) + __uint_as_float(rr[1]); }
    const float rl = lrun > 0.f ? 1.0f / lrun : 0.f;
    bf16* Og = (bf16*)(C.ws + (part ? WS_ATT1 : WS_ATT));
    float* Lg = (float*)(C.ws + (part ? WS_L1 : WS_L0));
    bf16* op = Og + (size_t)(rowbase + qg) * 512 + h * 64 + 4 * hi;
#pragma unroll
    for (int g = 0; g < 4; ++g) {
        u32x2 w0 = {cvtpk(o0[4 * g] * rl, o0[4 * g + 1] * rl), cvtpk(o0[4 * g + 2] * rl, o0[4 * g + 3] * rl)};
        u32x2 w1 = {cvtpk(o1[4 * g] * rl, o1[4 * g + 1] * rl), cvtpk(o1[4 * g + 2] * rl, o1[4 * g + 3] * rl)};
        *(u32x2*)(op + 8 * g) = w0; *(u32x2*)(op + 32 + 8 * g) = w1;
    }
    if (hi == 0) { Lg[(size_t)(rowbase + qg) * NH + h] = lrun; if (!split) WSP(float, WS_L1)[(size_t)(rowbase + qg) * NH + h] = 0.f; }
    asm volatile("s_waitcnt vmcnt(0) lgkmcnt(0)" ::: "memory");
    __builtin_amdgcn_s_barrier();
    asm volatile("" ::: "memory");
}
__device__ __forceinline__ P0It cv_decode(const Ctx& C, int j, int s) {
    P0It r; r.fp8 = 1;
    const int w = s & 7, i = s >> 3, kk = i & 1, t = i >> 1;
    if (j < 512) { const int e = j >> 4, kb = 2 * ((j >> 1) & 7) + kk, nb = (j & 1) * 32 + w + 8 * t, pn = nb >> 3, c0 = (nb & 7) * 32;
        const int src = (c0 < 128) ? 128 * pn + c0 : 1024 + 128 * pn + (c0 - 128);
        r.src = C.in[19] + (size_t)e * DM * 2048 + (size_t)(kb * 64) * 2048 + src; r.ldw = 2048;
        r.dst = C.ws + WS_WGU + ((size_t)e * 2048 + nb * 32) * 1024 + kb * 64; }
    else { const int jj = j - 512, e = jj >> 3, kb = 2 * (jj & 7) + kk, nb = w + 8 * t;
        r.src = C.in[21] + (size_t)e * DM * DM + (size_t)(kb * 64) * DM + nb * 32; r.ldw = DM;
        r.dst = C.ws + WS_WDN + ((size_t)e * DM + nb * 32) * 1024 + kb * 64; }
    return r;
}
#define CV_DECODE cv_decode
#define CV_LOAD p0_load
#define CV_STORE p0_store
__device__ __forceinline__ void conv_item(const Ctx& C, int jq) {
    const int j = jq >> 2, t = jq & 3, n = C.lane & 31, kh = C.lane >> 5;
    const P0It I = CV_DECODE(C, j, C.wave + 8 * (2 * t + kh));
    const float* s = I.src + n; const size_t ldw = (size_t)I.ldw;
    float v[64];
#pragma unroll
    for (int kq = 0; kq < 64; ++kq) v[kq] = s[kq * ldw];
    unsigned char* d = I.dst + (size_t)n * 1024;
#pragma unroll
    for (int q = 0; q < 4; ++q) {
        v4u o;
        o.x = pk_fp8x4(v[16 * q] * 32.f, v[16 * q + 1] * 32.f, v[16 * q + 2] * 32.f, v[16 * q + 3] * 32.f); o.y = pk_fp8x4(v[16 * q + 4] * 32.f, v[16 * q + 5] * 32.f, v[16 * q + 6] * 32.f, v[16 * q + 7] * 32.f);
        o.z = pk_fp8x4(v[16 * q + 8] * 32.f, v[16 * q + 9] * 32.f, v[16 * q + 10] * 32.f, v[16 * q + 11] * 32.f); o.w = pk_fp8x4(v[16 * q + 12] * 32.f, v[16 * q + 13] * 32.f, v[16 * q + 14] * 32.f, v[16 * q + 15] * 32.f);
        *(v4u*)(d + 16 * q) = o;
    }
}
__device__ __forceinline__ void conv_items3(const Ctx& C, int jq0) { conv_item(C, jq0); conv_item(C, jq0 + 1); conv_item(C, jq0 + 2); }
__device__ __forceinline__ int attn_build_items(const Ctx& C, float thr2, LAS unsigned* items) {
    LAS float* cb = (LAS float*)(C.lds + CV_SCR_OFF);
    LAS int* wcnt = (LAS int*)(C.lds + P2_MISC_OFF);
    LAS int* woff = wcnt + 8 * 33;
    const float* c2 = WSP(float, WS_C2);
    { float t_[4];
#pragma unroll
      for (int i = 0; i < 4; ++i) { const int idx = C.tid + i * NWAVES * 64; t_[i] = c2[(size_t)(idx >> 6) * SEQ + (idx & 63) * 64 + 63]; }
#pragma unroll
      for (int i = 0; i < 4; ++i) cb[C.tid + i * NWAVES * 64] = t_[i]; }
    __syncthreads();
    const int u = C.tid, bh = u >> 4, qb = u & 15, NTl = 4 * (qb + 1);
    const float cq0 = c2[(size_t)bh * SEQ + qb * 256];
    int ts = 0;
#pragma unroll 1
    for (int i = 0; i < NTl; ++i) ts = (cq0 - cb[bh * 64 + i] < thr2) ? i + 1 : ts;
    if (ts >= NTl) ts = NTl - 1;
    const int n = NTl - ts, split = n > 32 ? 1 : 0, n0 = split ? (n + 1) / 2 : n;
    const int costA = n0, costB = n - n0;
    const unsigned itemA = (unsigned)u | ((unsigned)split << 10) | ((unsigned)ts << 11) | ((unsigned)(ts + n0) << 18);
    const unsigned itemB = (unsigned)u | (1u << 9) | (1u << 10) | ((unsigned)(ts + n0) << 11) | ((unsigned)NTl << 18);
    const unsigned long long ltmask = (1ull << C.lane) - 1ull;
#pragma unroll 1
    for (int c = 0; c <= 32; ++c) { const unsigned long long bA = __ballot(costA == c), bB = __ballot(costB == c); if (C.lane == 0) wcnt[C.wave * 33 + c] = __popcll(bA) + __popcll(bB); }
    __syncthreads();
    if (C.tid < 8 * 33) { const int w = C.tid / 33, c = C.tid % 33; int off = 0;
        for (int c2_ = 32; c2_ > c; --c2_) for (int w2 = 0; w2 < 8; ++w2) off += wcnt[w2 * 33 + c2_];
        for (int w2 = 0; w2 < w; ++w2) off += wcnt[w2 * 33 + c];
        woff[C.tid] = off; }
    __syncthreads();
    int posA = 0, posB = 0;
#pragma unroll 1
    for (int c = 0; c <= 32; ++c) { const unsigned long long bA = __ballot(costA == c), bB = __ballot(costB == c); const int base = woff[C.wave * 33 + c];
        if (costA == c) posA = base + __popcll(bA & ltmask);
        if (costB == c) posB = base + __popcll(bA) + __popcll(bB & ltmask); }
    if (costA > 0) items[posA] = itemA;
    if (costB > 0) items[posB] = itemB;
    const int NA = woff[0];
    const int NBIG = woff[CV_COST - 1];
    __syncthreads();
    return NA | (NBIG << 16);
}
__device__ __forceinline__ void attn_phase(const Ctx& C) {
    const float qm = wave_max(fabsf(C.in[11][C.lane])), km = wave_max(fabsf(C.in[12][C.lane]));
    const float smax = 8.0f * qm * km * 1.05f;
    const float thr2 = -(SKIP_T + 2.0f * smax) * LOG2E, sref = smax * LOG2E;
    LAS unsigned* items = (LAS unsigned*)(C.lds + P2_LIST_OFF);
    LAS int* qn = (LAS int*)(C.lds + P2_MISC_OFF + 2304);
    const int nab_ = attn_build_items(C, thr2, items), NA = nab_ & 0xffff;
    unsigned* qA = (unsigned*)(C.ws + WS_CTL) + CW_QUEUE; unsigned* qC = (unsigned*)(C.ws + WS_CTL) + CW_QUEUE2;
#ifdef CONV_IN_P0
    const int ncv_ = 0;
#else
    const int ncv_ = (C.G == 256) ? NCV : NCV_ALL;
#endif
#ifndef CF_SEL
#define CF_SEL(bx) ((((bx) >> 3) & 3) == 3)
#endif
    int mode = CF_SEL((int)blockIdx.x) ? 1 : 0, tried = 0;
    if (C.tid == 0) qn[0] = (int)__hip_atomic_fetch_add(mode ? qC : qA, 1u, __ATOMIC_RELAXED, __HIP_MEMORY_SCOPE_AGENT);
    __syncthreads();
    int cur = qn[0];
    for (;;) {
        if (cur >= (mode ? ncv_ : NA)) {
            if (tried) break;
            tried = 1; mode ^= 1;
            __syncthreads();
            if (C.tid == 0) qn[0] = (int)__hip_atomic_fetch_add(mode ? qC : qA, 1u, __ATOMIC_RELAXED, __HIP_MEMORY_SCOPE_AGENT);
            __syncthreads();
            cur = qn[0];
            continue;
        }
        int nxt = 0;
        if (C.tid == 0) nxt = (int)__hip_atomic_fetch_add(mode ? qC : qA, 1u, __ATOMIC_RELAXED, __HIP_MEMORY_SCOPE_AGENT);
        if (mode) conv_item(C, cur); else attn_item(C, items[cur], sref);
        __syncthreads();
        if (C.tid == 0) qn[0] = nxt;
        __syncthreads();
        cur = qn[0];
    }
}

struct PostRow { v4u hp0, hp1; v4u gw, aw, aw1; float lp0, lp1; };
__device__ __forceinline__ void post_load(const Ctx& C, PostRow& R, size_t row, int c8, int lane) {
    const unsigned* HP = WSP(unsigned, WS_HLOC); const bf16* GG = WSP(bf16, WS_GG); const bf16* ATT = WSP(bf16, WS_ATT); const bf16* ATT1 = WSP(bf16, WS_ATT1);
    R.hp0 = *(const v4u*)(HP + row * 512 + c8); R.hp1 = *(const v4u*)(HP + row * 512 + c8 + 4);
    R.gw = *(const v4u*)(GG + row * 512 + c8); R.aw = *(const v4u*)(ATT + row * 512 + c8); R.aw1 = *(const v4u*)(ATT1 + row * 512 + c8);
    R.lp0 = WSP(float, WS_L0)[row * NH + (lane >> 3)]; R.lp1 = WSP(float, WS_L1)[row * NH + (lane >> 3)];
}
__device__ __forceinline__ void post_phase(const Ctx& C, int unit) {
    const int b = unit >> 6, ch = unit & 63;
    LAS float* CA = (LAS float*)C.lds;
    LAS float* CB = CA + 8 * 512;
    LAS float* Hc = CB + 8 * 512;
    const int c8 = 8 * C.lane;
    {
        const float* A = WSP(float, WS_AEND) + (size_t)b * NCHUNK * 512 + c8; const float* B = WSP(float, WS_BEND) + (size_t)b * NCHUNK * 512 + c8;
        f32x4 a0 = {1.f, 1.f, 1.f, 1.f}, a1 = a0, b0 = {0.f, 0.f, 0.f, 0.f}, b1 = b0;
        f32x4 va[8][2], vb[8][2];
#pragma unroll
        for (int i = 0; i < 8; ++i) { const int k = 8 * C.wave + i, kc = k < ch ? k : 0;
            va[i][0] = *(const f32x4*)(A + (size_t)kc * 512); va[i][1] = *(const f32x4*)(A + (size_t)kc * 512 + 4); vb[i][0] = *(const f32x4*)(B + (size_t)kc * 512); vb[i][1] = *(const f32x4*)(B + (size_t)kc * 512 + 4); }
#pragma unroll
        for (int i = 0; i < 8; ++i) { if (8 * C.wave + i < ch) { b0 = va[i][0] * b0 + vb[i][0]; b1 = va[i][1] * b1 + vb[i][1]; a0 = a0 * va[i][0]; a1 = a1 * va[i][1]; } }
        *(LAS f32x4*)(CA + C.wave * 512 + c8) = a0; *(LAS f32x4*)(CA + C.wave * 512 + c8 + 4) = a1; *(LAS f32x4*)(CB + C.wave * 512 + c8) = b0; *(LAS f32x4*)(CB + C.wave * 512 + c8 + 4) = b1;
    }
    __syncthreads();
    { float H = 0.f;
#pragma unroll
      for (int w = 0; w < 8; ++w) H = CA[w * 512 + C.tid] * H + CB[w * 512 + C.tid];
      Hc[C.tid] = H; }
    __syncthreads();
    bf16* MIX = WSP(bf16, WS_MIX);
    const f32x4 h0 = *(const LAS f32x4*)(Hc + c8), h1 = *(const LAS f32x4*)(Hc + c8 + 4);
    const f32x4 wr0 = *(const f32x4*)(C.in[13] + c8), wr1 = *(const f32x4*)(C.in[13] + c8 + 4), wa0 = *(const f32x4*)(C.in[14] + c8), wa1 = *(const f32x4*)(C.in[14] + c8 + 4);
    const size_t rowb = (size_t)b * SEQ + ch * CHUNK + C.wave * 8;
    PostRow R, Rn; post_load(C, R, rowb, c8, C.lane);
#pragma unroll 1
    for (int i = 0; i < 8; ++i) {
        const size_t row = rowb + i;
        post_load(C, Rn, rowb + (i < 7 ? i + 1 : 7), c8, C.lane);
        const float rl01 = 1.0f / (R.lp0 + R.lp1), f0 = R.lp0 * rl01, f1 = R.lp1 * rl01;
        f32x4 r0 = {bflo(R.hp0.x) + bfhi(R.hp0.x) * h0.x, bflo(R.hp0.y) + bfhi(R.hp0.y) * h0.y, bflo(R.hp0.z) + bfhi(R.hp0.z) * h0.z, bflo(R.hp0.w) + bfhi(R.hp0.w) * h0.w};
        f32x4 r1 = {bflo(R.hp1.x) + bfhi(R.hp1.x) * h1.x, bflo(R.hp1.y) + bfhi(R.hp1.y) * h1.y, bflo(R.hp1.z) + bfhi(R.hp1.z) * h1.z, bflo(R.hp1.w) + bfhi(R.hp1.w) * h1.w};
        r0.x *= bflo(R.gw.x); r0.y *= bfhi(R.gw.x); r0.z *= bflo(R.gw.y); r0.w *= bfhi(R.gw.y); r1.x *= bflo(R.gw.z); r1.y *= bfhi(R.gw.z); r1.z *= bflo(R.gw.w); r1.w *= bfhi(R.gw.w);
        float ss = (r0.x * r0.x + r0.y * r0.y) + (r0.z * r0.z + r0.w * r0.w) + (r1.x * r1.x + r1.y * r1.y) + (r1.z * r1.z + r1.w * r1.w);
        f32x4 a0 = {bflo(R.aw.x), bfhi(R.aw.x), bflo(R.aw.y), bfhi(R.aw.y)}, a1 = {bflo(R.aw.z), bfhi(R.aw.z), bflo(R.aw.w), bfhi(R.aw.w)};
        a0 = a0 * f0; a1 = a1 * f0;
        if (R.lp1 > 0.f) { const f32x4 q0 = {bflo(R.aw1.x), bfhi(R.aw1.x), bflo(R.aw1.y), bfhi(R.aw1.y)}, q1 = {bflo(R.aw1.z), bfhi(R.aw1.z), bflo(R.aw1.w), bfhi(R.aw1.w)}; a0 += q0 * f1; a1 += q1 * f1; }
        float sa = (a0.x * a0.x + a0.y * a0.y) + (a0.z * a0.z + a0.w * a0.w) + (a1.x * a1.x + a1.y * a1.y) + (a1.z * a1.z + a1.w * a1.w);
        const float rs = 1.0f / sqrtf(wave_sum(ss) * (1.0f / DREC) + EPS), ra = 1.0f / sqrtf(wave_sum(sa) * (1.0f / DATT) + EPS);
        r0 = r0 * rs * wr0; r1 = r1 * rs * wr1; a0 = a0 * ra * wa0; a1 = a1 * ra * wa1;
        *(v4u*)(MIX + row * DM + c8) = (v4u){cvtpk(r0.x, r0.y), cvtpk(r0.z, r0.w), cvtpk(r1.x, r1.y), cvtpk(r1.z, r1.w)};
        *(v4u*)(MIX + row * DM + 512 + c8) = (v4u){cvtpk(a0.x, a0.y), cvtpk(a0.z, a0.w), cvtpk(a1.x, a1.y), cvtpk(a1.z, a1.w)};
        R = Rn;
    }
    __syncthreads();
}

struct EpiRes {
    static constexpr bool PERM = true, AFTER_DRAIN = false;
    const float* x; bf16* x1b; unsigned char* xb; const float* ln2;
    __device__ __forceinline__ void operator()(const pg8::f32x4 (&acc)[2][2][4][2], const pg8::Unit& u, int wr, int wc, int fr, int fq) const {
        const int row0 = u.pm * 256 + wr * 64 + fr, col0 = u.pn * 256 + wc * 32 + 8 * fq;
        pg8::f32x4 lw[2][2];
#pragma unroll
        for (int bj = 0; bj < 2; ++bj)
#pragma unroll
            for (int n = 0; n < 2; ++n) lw[bj][n] = *(const pg8::f32x4*)(ln2 + col0 + bj * 128 + 4 * n);
#pragma unroll
        for (int ai = 0; ai < 2; ++ai)
#pragma unroll
            for (int m = 0; m < 4; ++m) { const size_t off = (size_t)(row0 + ai * 128 + m * 16) * DM + col0;
#pragma unroll
                for (int bj = 0; bj < 2; ++bj) { u32x2 w; v4u xw;
#pragma unroll
                    for (int n = 0; n < 2; ++n) { const pg8::f32x4 xv = *(const pg8::f32x4*)(x + off + bj * 128 + 4 * n) + acc[ai][bj][m][n]; xw[2 * n] = cvtpk(xv[0], xv[1]); xw[2 * n + 1] = cvtpk(xv[2], xv[3]);
                        const pg8::f32x4 q = xv * lw[bj][n]; w[n] = pk_fp8x4(q[0], q[1], q[2], q[3]); }
                    *(v4u*)(x1b + off + bj * 128) = xw; *(u32x2*)(xb + off + bj * 128) = w; } }
    }
};

__device__ __forceinline__ void split_bf16x8(const float (&v)[8], bf16x8& h, bf16x8& l) {
    v4u ph, pl;
#pragma unroll
    for (int i = 0; i < 4; ++i) { const unsigned p = cvtpk(v[2 * i], v[2 * i + 1]); ph[i] = p; pl[i] = cvtpk(v[2 * i] - bflo(p), v[2 * i + 1] - bfhi(p)); }
    h = __builtin_bit_cast(bf16x8, ph); l = __builtin_bit_cast(bf16x8, pl);
}
__device__ __forceinline__ void router_phase(const Ctx& C, bool dry = false) {
    LAS float* PART = (LAS float*)C.lds;
    LAS float* SSP = PART + 8 * 64 * 32;
    LAS float* LG = SSP + 8 * 64;
    LAS int* lcnt = (LAS int*)(C.lds + TAB_OFF);
    LAS int* gbase = lcnt + 32;
    LAS int* te = gbase + 32;
    LAS int* tp = te + 256;
    LAS float* tg = (LAS float*)(tp + 256);
    if (C.tid < 32) lcnt[C.tid] = 0;
    __syncthreads();
    const bf16* x1 = WSP(bf16, WS_X1B); const float* br = C.in[18]; const float* wr = C.in[17]; const float* ln2 = C.in[16];
    const size_t dofs = dry ? (size_t)(700 * MiB) : 0;
    float* RSTD2 = (float*)(C.ws + WS_RSTD2 + dofs); int* TKE = (int*)(C.ws + WS_TKE + dofs); int* TKP = (int*)(C.ws + WS_TKP + dofs); float* TKG = (float*)(C.ws + WS_TKG + dofs);
    unsigned* cnt = (unsigned*)(C.ws + WS_CTL + dofs) + CW_CNT;
    const int w = C.wave, l32 = C.lane & 31, hi = C.lane >> 5;
    for (int unit = C.vcu; unit < M / 64; unit += C.G) {
        const int t0 = unit * 64;
        f32x16 acc0 = {}, acc1 = {}; float ss0 = 0.f, ss1 = 0.f;
#pragma unroll
        for (int ks = 0; ks < 8; ++ks) {
            const int d0 = 128 * w + 16 * ks + 8 * hi;
            float bw[8];
            { const float* wp = wr + (size_t)d0 * NE + l32; const f32x4 la = *(const f32x4*)(ln2 + d0), lb = *(const f32x4*)(ln2 + d0 + 4);
              bw[0] = wp[0] * la.x; bw[1] = wp[32] * la.y; bw[2] = wp[64] * la.z; bw[3] = wp[96] * la.w; bw[4] = wp[128] * lb.x; bw[5] = wp[160] * lb.y; bw[6] = wp[192] * lb.z; bw[7] = wp[224] * lb.w; }
            bf16x8 wh, wl; split_bf16x8(bw, wh, wl);
            { const v4u raw = *(const v4u*)(x1 + (size_t)(t0 + l32) * DM + d0);
              const float av[8] = {bflo(raw.x), bfhi(raw.x), bflo(raw.y), bfhi(raw.y), bflo(raw.z), bfhi(raw.z), bflo(raw.w), bfhi(raw.w)};
#pragma unroll
              for (int j = 0; j < 8; ++j) ss0 += av[j] * av[j];
              const bf16x8 xh = __builtin_bit_cast(bf16x8, raw);
              acc0 = __builtin_amdgcn_mfma_f32_32x32x16_bf16(xh, wh, acc0, 0, 0, 0); acc0 = __builtin_amdgcn_mfma_f32_32x32x16_bf16(xh, wl, acc0, 0, 0, 0); }
            { const v4u raw = *(const v4u*)(x1 + (size_t)(t0 + 32 + l32) * DM + d0);
              const float av[8] = {bflo(raw.x), bfhi(raw.x), bflo(raw.y), bfhi(raw.y), bflo(raw.z), bfhi(raw.z), bflo(raw.w), bfhi(raw.w)};
#pragma unroll
              for (int j = 0; j < 8; ++j) ss1 += av[j] * av[j];
              const bf16x8 xh = __builtin_bit_cast(bf16x8, raw);
              acc1 = __builtin_amdgcn_mfma_f32_32x32x16_bf16(xh, wh, acc1, 0, 0, 0); acc1 = __builtin_amdgcn_mfma_f32_32x32x16_bf16(xh, wl, acc1, 0, 0, 0); }
        }
#pragma unroll
        for (int r = 0; r < 16; ++r) { PART[(w * 64 + crow(r, hi)) * 32 + l32] = acc0[r]; PART[(w * 64 + 32 + crow(r, hi)) * 32 + l32] = acc1[r]; }
        ss0 += __shfl_xor(ss0, 32); ss1 += __shfl_xor(ss1, 32);
        if (hi == 0) { SSP[w * 64 + l32] = ss0; SSP[w * 64 + 32 + l32] = ss1; }
        __syncthreads();
        { const int tl = C.tid >> 3, e4 = C.tid & 7; f32x4 s = {0.f, 0.f, 0.f, 0.f}; float sq = 0.f;
#pragma unroll
          for (int w2 = 0; w2 < 8; ++w2) { s += *(const LAS f32x4*)(PART + (w2 * 64 + tl) * 32 + 4 * e4); sq += SSP[w2 * 64 + tl]; }
          const float rstd = 1.0f / sqrtf(sq * (1.0f / DM) + EPS); const f32x4 bb = *(const f32x4*)(br + 4 * e4);
          LG[tl * 33 + 4 * e4] = s.x * rstd + bb.x; LG[tl * 33 + 4 * e4 + 1] = s.y * rstd + bb.y; LG[tl * 33 + 4 * e4 + 2] = s.z * rstd + bb.z; LG[tl * 33 + 4 * e4 + 3] = s.w * rstd + bb.w;
          if (e4 == 0) RSTD2[t0 + tl] = rstd; }
        __syncthreads();
        if (C.tid < 64) {
            const int tl = C.tid; float lg[32];
#pragma unroll
            for (int e = 0; e < 32; ++e) lg[e] = LG[tl * 33 + e];
            float tv[4]; int ti[4];
#pragma unroll
            for (int k = 0; k < 4; ++k) { float best = -INFINITY; int bi = 0;
#pragma unroll
                for (int e = 0; e < 32; ++e) { const bool gt = lg[e] > best; best = gt ? lg[e] : best; bi = gt ? e : bi; }
                tv[k] = best; ti[k] = bi;
#pragma unroll
                for (int e = 0; e < 32; ++e) lg[e] = (e == bi) ? -INFINITY : lg[e]; }
            const float e1 = fast_exp(tv[1] - tv[0]), e2 = fast_exp(tv[2] - tv[0]), e3 = fast_exp(tv[3] - tv[0]); const float inv = 1.0f / (1.0f + e1 + e2 + e3);
            const float gk[4] = {inv, e1 * inv, e2 * inv, e3 * inv};
#pragma unroll
            for (int k = 0; k < 4; ++k) { const int lp = __hip_atomic_fetch_add(lcnt + ti[k], 1, __ATOMIC_RELAXED, __HIP_MEMORY_SCOPE_WORKGROUP); te[tl * 4 + k] = ti[k]; tp[tl * 4 + k] = lp; }
            *(f32x4*)(TKG + (size_t)(t0 + tl) * 4) = (f32x4){gk[0], gk[1], gk[2], gk[3]};
#pragma unroll
            for (int k = 0; k < 4; ++k) tg[tl * 4 + k] = gk[k];
        }
        __syncthreads();
        if (C.tid < 32) { gbase[C.tid] = (int)__hip_atomic_fetch_add(cnt + 64 * C.tid, (unsigned)lcnt[C.tid], __ATOMIC_RELAXED, __HIP_MEMORY_SCOPE_AGENT); }
        __syncthreads();
        if (C.tid < 256) { const int e = te[C.tid], pos = gbase[e] + tp[C.tid]; TKE[(size_t)unit * 256 + C.tid] = e; TKP[(size_t)unit * 256 + C.tid] = pos;
            if (!dry) { WSP(int, WS_LIST)[(size_t)e * M + pos] = t0 + (C.tid >> 2); WSP(float, WS_LISTG)[(size_t)e * M + pos] = tg[C.tid]; } }
        __syncthreads();
        if (C.tid < 32) lcnt[C.tid] = 0;
        __syncthreads();
    }
}

__device__ __forceinline__ void build_tables(const Ctx& C) {
    LAS int* padstart = (LAS int*)(C.lds + TAB_OFF);
    LAS int* tile_e = padstart + 40;
    const unsigned* cnt = (const unsigned*)(C.ws + WS_CTL) + CW_CNT;
    LAS int* cntl = padstart + 40 + MAXMT;
    if (C.tid < NE) cntl[C.tid] = (int)__hip_atomic_load(cnt + 64 * C.tid, __ATOMIC_RELAXED, __HIP_MEMORY_SCOPE_AGENT);
    __syncthreads();
    if (C.tid == 0) { int acc = 0; for (int e = 0; e < NE; ++e) { padstart[e] = acc; acc += (cntl[e] + 255) & ~255; } padstart[NE] = acc; }
    __syncthreads();
    if (C.tid < MAXMT) { const int r = C.tid * 256; int e = 0;
#pragma unroll 1
        for (int k = 1; k < NE; ++k) e = (padstart[k] <= r) ? k : e;
        tile_e[C.tid] = e; }
    __syncthreads();
}

struct GRow { f32x4 x[4]; float rstd; int e[4], p[4]; f32x4 g; };
__device__ __forceinline__ void gather_load(const Ctx& C, GRow& R, int t) {
    const f32x4* xr = (const f32x4*)(C.out + (size_t)t * DM) + C.lane;
#pragma unroll
    for (int jj = 0; jj < 4; ++jj) R.x[jj] = xr[64 * jj];
    R.rstd = WSP(float, WS_RSTD2)[t];
    const v4u ev = *(const v4u*)(WSP(int, WS_TKE) + (size_t)t * 4), pv = *(const v4u*)(WSP(int, WS_TKP) + (size_t)t * 4);
    R.e[0] = ev.x; R.e[1] = ev.y; R.e[2] = ev.z; R.e[3] = ev.w; R.p[0] = pv.x; R.p[1] = pv.y; R.p[2] = pv.z; R.p[3] = pv.w;
    R.g = *(const f32x4*)(WSP(float, WS_TKG) + (size_t)t * 4);
}
__device__ __forceinline__ void gather_phase(const Ctx& C) {
    const LAS int* padstart = (const LAS int*)(C.lds + TAB_OFF);
    const float* ln2 = C.in[16];
    unsigned char* XS = C.ws + WS_XS; float* SLOTG = WSP(float, WS_SLOTG);
    f32x4 w[4];
#pragma unroll
    for (int jj = 0; jj < 4; ++jj) w[jj] = *(const f32x4*)(ln2 + 4 * C.lane + 256 * jj);
    const int gw = C.vcu * NWAVES + C.wave, NGW = C.G * NWAVES;
    GRow R, Rn; gather_load(C, R, gw < M ? gw : M - 1);
    for (int t = gw; t < M; t += NGW) {
        gather_load(C, Rn, (t + NGW < M) ? t + NGW : t);
        unsigned pk[4];
#pragma unroll
        for (int jj = 0; jj < 4; ++jj) { const f32x4 v = R.x[jj] * R.rstd * w[jj]; pk[jj] = pk_fp8x4(v.x, v.y, v.z, v.w); }
        const float gk[4] = {R.g.x, R.g.y, R.g.z, R.g.w};
#pragma unroll
        for (int k = 0; k < 4; ++k) { const int slot = padstart[R.e[k]] + R.p[k];
            unsigned* o4 = (unsigned*)(XS + (size_t)slot * DM) + C.lane;
#pragma unroll
            for (int jj = 0; jj < 4; ++jj) o4[64 * jj] = pk[jj];
            if (C.lane == 0) SLOTG[slot] = gk[k]; }
        R = Rn;
    }
}


__device__ __forceinline__ int fresh_lane() { int l = __builtin_amdgcn_mbcnt_hi(~0u, __builtin_amdgcn_mbcnt_lo(~0u, 0u)); asm volatile("" : "+v"(l)); return l; }
constexpr float WSCALE_INV = 1.0f / 32.0f, HSCALE = 4.0f;
struct MoeOrder {
    int nM, nN, nwg, G, c; const LAS int* tile_e;
    __device__ __forceinline__ bool next(int i, pg8::Unit& u) const {
        const long L = (long)i * G + c; if (L >= nwg) return false;
        int wgid = (int)L; { const int q = nwg / 8, r = nwg % 8, xcd = wgid % 8, off = wgid / 8; wgid = (xcd < r ? xcd * (q + 1) : r * (q + 1) + (xcd - r) * q) + off; }
        const int nig = 8 * nN, gid = wgid / nig, fm = gid * 8, gsz = (nM - fm) < 8 ? (nM - fm) : 8;
        const int pm = fm + ((wgid % nig) % gsz), pnl = (wgid % nig) / gsz;
        u.pm = pm; u.pn = tile_e[pm] * nN + pnl; return true;
    }
    __device__ __forceinline__ void a_ready(const pg8::Unit&) const {}
    __device__ __forceinline__ void done(const pg8::Unit&) const {}
};
constexpr int TOKT_OFF = 131072, TOKR_OFF = TOKT_OFF + 10 * 1024;
struct MoeGatherOrder {
    int nM, nN, nwg, G, c; const LAS int* tile_e; const LAS int* tokt;
    __device__ __forceinline__ bool next(int i, pg8::Unit& u) const {
        const long L = (long)i * G + c; if (L >= nwg) return false;
        int wgid = (int)L; { const int q = nwg / 8, r = nwg % 8, xcd = wgid % 8, off = wgid / 8; wgid = (xcd < r ? xcd * (q + 1) : r * (q + 1) + (xcd - r) * q) + off; }
        const int nig = 8 * nN, gid = wgid / nig, fm = gid * 8, gsz = (nM - fm) < 8 ? (nM - fm) : 8;
        const int pm = fm + ((wgid % nig) % gsz), pnl = (wgid % nig) / gsz;
        u.pm = pm; u.pn = (i << 16) | (tile_e[pm] * nN + pnl); return true;
    }
    __device__ __forceinline__ int arow(int ui, int r) const { return tokt[ui * 256 + r]; }
    __device__ __forceinline__ void a_ready(const pg8::Unit&) const {}
    __device__ __forceinline__ void done(const pg8::Unit&) const {}
};
__device__ __forceinline__ void fill_unit_tables(const Ctx& C, const MoeGatherOrder& S) {
    const LAS int* padstart = (const LAS int*)(C.lds + TAB_OFF); const LAS int* cntl = padstart + 40 + MAXMT;
    LAS int* tokt = (LAS int*)(C.lds + TOKT_OFF); LAS float* tokr = (LAS float*)(C.lds + TOKR_OFF);
    const int* LIST = WSP(int, WS_LIST); const float* RSTD2 = WSP(float, WS_RSTD2);
    if (C.tid < 256) {
        int tok[10]; float rs[10]; bool ok[10];
        pg8::Unit u;
#pragma unroll
        for (int i = 0; i < 10; ++i) { ok[i] = S.next(i, u); const int pm = ok[i] ? u.pm : 0; const int e = S.tile_e[pm], idx = pm * 256 - padstart[e] + C.tid; tok[i] = LIST[(size_t)e * M + ((ok[i] && idx < cntl[e]) ? idx : 0)]; }
#pragma unroll
        for (int i = 0; i < 10; ++i) rs[i] = RSTD2[tok[i]];
#pragma unroll
        for (int i = 0; i < 10; ++i) if (ok[i]) { tokt[i * 256 + C.tid] = tok[i]; tokr[i * 256 + C.tid] = rs[i]; }
    }
    __syncthreads();
}
struct EpiGateUp {
    static constexpr bool PERM = true, AFTER_DRAIN = false;
    unsigned char* H; const float* bgu; const LAS float* tokr;
    __device__ __forceinline__ void operator()(const pg8::f32x4 (&acc)[2][2][4][2], const pg8::Unit& u, int wr, int wc, int, int) const {
        const int l_ = fresh_lane(), fr = l_ & 15, fq = l_ >> 4;
        const int ui = u.pn >> 16, en = u.pn & 0xffff, e = en >> 3, pnl = en & 7, rl0 = wr * 64 + fr, row0 = u.pm * 256 + rl0, col0 = 128 * pnl + 32 * wc + 8 * fq;
        const float* bg = bgu + (size_t)e * 2048 + col0;
        pg8::f32x4 bgv[2], buv[2];
#pragma unroll
        for (int n = 0; n < 2; ++n) { bgv[n] = *(const pg8::f32x4*)(bg + 4 * n); buv[n] = *(const pg8::f32x4*)(bg + 1024 + 4 * n); }
#pragma unroll
        for (int ai = 0; ai < 2; ++ai)
#pragma unroll
            for (int m = 0; m < 4; ++m) { unsigned char* rowp = H + (size_t)(row0 + ai * 128 + m * 16) * DM + col0; u32x2 w; const float rs = tokr[ui * 256 + rl0 + ai * 128 + m * 16] * WSCALE_INV;
#pragma unroll
                for (int n = 0; n < 2; ++n) {
                    pg8::f32x4 g = acc[ai][0][m][n] * rs + bgv[n], uu = acc[ai][1][m][n] * rs + buv[n];
#pragma unroll
                    for (int j = 0; j < 4; ++j) { g[j] = fminf(g[j], 7.0f); uu[j] = __builtin_amdgcn_fmed3f(uu[j], -7.0f, 7.0f); }
                    pg8::f32x4 ex = g * (-1.702f * LOG2E);
#pragma unroll
                    for (int j = 0; j < 4; ++j) ex[j] = __builtin_amdgcn_exp2f(ex[j]);
                    pg8::f32x4 den = ex + 1.0f;
#pragma unroll
                    for (int j = 0; j < 4; ++j) den[j] = __builtin_amdgcn_rcpf(den[j]);
                    const pg8::f32x4 a = (uu * HSCALE + HSCALE) * (g * den);
                    w[n] = pk_fp8x4(a[0], a[1], a[2], a[3]); }
                *(u32x2*)rowp = w; }
    }
};
constexpr float YSCALE = 16.0f;
struct EpiDown {
    static constexpr bool PERM = true, AFTER_DRAIN = false;
    unsigned char* Y; const float* bd; const float* listg; const LAS int* padstart;
    __device__ __forceinline__ void operator()(const pg8::f32x4 (&acc)[2][2][4][2], const pg8::Unit& u, int wr, int wc, int, int) const {
        const int l_ = fresh_lane(), fr = l_ & 15, fq = l_ >> 4;
        const int e = u.pn >> 2, pnl = u.pn & 3, row0 = u.pm * 256 + wr * 64 + fr, col0 = 256 * pnl + 32 * wc + 8 * fq;
        const float* bp = bd + (size_t)e * DM + col0;
        const int ps = padstart[e], ce = padstart[40 + MAXMT + e]; const float* lg = listg + (size_t)e * M;
        pg8::f32x4 bv[2][2];
#pragma unroll
        for (int bj = 0; bj < 2; ++bj)
#pragma unroll
            for (int n = 0; n < 2; ++n) bv[bj][n] = *(const pg8::f32x4*)(bp + 128 * bj + 4 * n);
#pragma unroll
        for (int ai = 0; ai < 2; ++ai)
#pragma unroll
            for (int m = 0; m < 4; ++m) { const int row = row0 + ai * 128 + m * 16, idx = row - ps; const float gt = (idx < ce ? lg[idx] : 0.f) * YSCALE; unsigned char* rowp = Y + (size_t)row * DM + col0;
#pragma unroll
                for (int bj = 0; bj < 2; ++bj) { const pg8::f32x4 v0 = (acc[ai][bj][m][0] * (WSCALE_INV / HSCALE) + bv[bj][0]) * gt, v1 = (acc[ai][bj][m][1] * (WSCALE_INV / HSCALE) + bv[bj][1]) * gt;
                    *(u32x2*)(rowp + 128 * bj) = (u32x2){pk_fp8x4(v0[0], v0[1], v0[2], v0[3]), pk_fp8x4(v1[0], v1[1], v1[2], v1[3])}; } }
    }
};

struct CIdx { v4u e, p; u32x2 x[4]; };
__device__ __forceinline__ void comb_idx(const Ctx& C, CIdx& I, int t) {
    I.e = *(const v4u*)(WSP(int, WS_TKE) + (size_t)t * 4); I.p = *(const v4u*)(WSP(int, WS_TKP) + (size_t)t * 4);
    const u32x2* xr = (const u32x2*)(WSP(bf16, WS_X1B) + (size_t)t * DM) + C.lane;
#pragma unroll
    for (int jj = 0; jj < 4; ++jj) I.x[jj] = xr[64 * jj];
}
__device__ __forceinline__ void comb_ys(const Ctx& C, const CIdx& I, unsigned (&y)[4][4], const LAS int* padstart) {
    const unsigned char* YS = C.ws + WS_YS;
    const unsigned ev[4] = {I.e.x, I.e.y, I.e.z, I.e.w}, pv[4] = {I.p.x, I.p.y, I.p.z, I.p.w};
#pragma unroll
    for (int k = 0; k < 4; ++k) { const int slot = padstart[ev[k]] + (int)pv[k]; const unsigned* yp = (const unsigned*)(YS + (size_t)slot * DM) + C.lane;
#pragma unroll
        for (int jj = 0; jj < 4; ++jj) y[k][jj] = yp[64 * jj]; }
}
__device__ __forceinline__ void combine_phase(const Ctx& C, bool dry = false) {
    const LAS int* padstart = (const LAS int*)(C.lds + TAB_OFF);
    float* out = C.out;
    const int gw = C.vcu * NWAVES + C.wave, NGW = C.G * NWAVES;
    if (gw >= M) return;
    CIdx I0, I1; unsigned y0[4][4], y1[4][4];
    comb_idx(C, I0, gw); comb_ys(C, I0, y0, padstart); comb_idx(C, I1, (gw + NGW < M) ? gw + NGW : gw);
    for (int t = gw; t < M; t += NGW) {
        comb_ys(C, I1, y1, padstart);
        CIdx I2; comb_idx(C, I2, (t + 2 * NGW < M) ? t + 2 * NGW : t);
        f32x4 v[4];
#pragma unroll
        for (int jj = 0; jj < 4; ++jj) v[jj] = (f32x4){bflo(I0.x[jj].x), bfhi(I0.x[jj].x), bflo(I0.x[jj].y), bfhi(I0.x[jj].y)};
#pragma unroll
        for (int k = 0; k < 4; ++k)
#pragma unroll
            for (int jj = 0; jj < 4; ++jj) { const unsigned y = y0[k][jj]; const f32x2 lo = __builtin_amdgcn_cvt_pk_f32_fp8((int)y, false), hi = __builtin_amdgcn_cvt_pk_f32_fp8((int)y, true);
                v[jj].x += lo.x * (1.0f / YSCALE); v[jj].y += lo.y * (1.0f / YSCALE); v[jj].z += hi.x * (1.0f / YSCALE); v[jj].w += hi.y * (1.0f / YSCALE); }
        f32x4* xw = dry ? (f32x4*)(C.ws + 576 * MiB + (size_t)t * DM * 4) + C.lane : (f32x4*)(out + (size_t)t * DM) + C.lane;
#pragma unroll
        for (int jj = 0; jj < 4; ++jj) xw[64 * jj] = v[jj];
        I0 = I1; I1 = I2;
#pragma unroll
        for (int k = 0; k < 4; ++k)
#pragma unroll
            for (int jj = 0; jj < 4; ++jj) y0[k][jj] = y1[k][jj];
    }
}

struct Args { const float* in[23]; float* out; unsigned char* ws; int ph_lo, ph_hi; };
__global__ void __launch_bounds__(NWAVES * 64, 2) fwd_kernel(Args args) {
    extern __shared__ __attribute__((aligned(16))) unsigned char lds[];
    Ctx C;
    C.lds = (LAS unsigned char*)lds;
    C.tid = threadIdx.x; C.lane = C.tid & 63; C.wave = __builtin_amdgcn_readfirstlane(C.tid >> 6);
    C.G = gridDim.x; { const int bx = blockIdx.x; C.vcu = (C.G % 8 == 0) ? (bx % 8) * (C.G / 8) + bx / 8 : bx; }
#pragma unroll
    for (int i = 0; i < 23; ++i) C.in[i] = args.in[i];
    C.out = args.out; C.ws = args.ws;
    volatile LAS unsigned* MISC = (volatile LAS unsigned*)(C.lds + MISC_OFF);
    for (int u = C.tid; u < (LDS_BYTES - LDSCTL_OFF) / 4; u += NWAVES * 64) ((LAS unsigned*)(C.lds + LDSCTL_OFF))[u] = 0u;
    __syncthreads();
    XcdBarrier bar; bar.bar = (unsigned*)(C.ws + WS_CTL) + CW_BAR; bar.x = 0; bar.st = nullptr;
    if (N_LAUNCHES != PER_PHASE) bar = xcd_barrier_post((unsigned*)(C.ws + WS_CTL) + CW_BAR, MISC + 8);
    const int lo = args.ph_lo, hi = args.ph_hi;
#ifndef PHASE_MASK
#define PHASE_MASK 0x3ff
#endif
#define IN(k) (((PHASE_MASK >> (k)) & 1) && lo <= (k) && (k) < hi)
#define BOTH(k) (IN(k) && IN((k) + 1))
#define GRID_BAR() do { if (N_LAUNCHES != PER_PHASE) xcd_barrier(bar); } while (0)
#ifdef PROBE_K
    unsigned long long pr_a = 0, pr_b = 0;
#define PSTAMP(k) do { if ((k) == PROBE_K) pr_a = __builtin_amdgcn_s_memrealtime(); if ((k) == PROBE_K + 1) pr_b = __builtin_amdgcn_s_memrealtime(); } while (0)
#else
#define PSTAMP(k) do {} while (0)
#endif

#ifndef REP0
#define REP0 1
#endif
#ifndef REP2
#define REP2 1
#endif
#ifndef REP1
#define REP1 1
#endif
#ifndef REP3
#define REP3 1
#endif
#ifndef REP4
#define REP4 1
#endif
#ifndef REP6
#define REP6 1
#endif
#ifndef REP7
#define REP7 1
#endif
#ifndef REP8
#define REP8 1
#endif
    PSTAMP(0);
    if (IN(0)) { for (int rep = 0; rep < REP0; ++rep) { p0_prologue(C); __syncthreads(); }
#ifdef CONV_IN_P0
        for (int j = C.vcu; j < NCV; j += C.G) conv_item(C, j);
        __syncthreads();
#endif
        if (BOTH(0)) GRID_BAR(); }

    PSTAMP(1);
    if (IN(1)) {
#ifndef NO_CUMSUM
        p1_cumsum(C);
#endif
        pg8::Gemm g{WSP(bf16, WS_XN), WSP(bf16, WS_WIN), M, NPROJ, DM}; pg8::StaticOrder S; S.init(M, NPROJ, C.G, (int)blockIdx.x);
        EpiInProj E{WSP(bf16, WS_U), C.in[11], C.in[12]};
        for (int rep = 0; rep < REP1; ++rep) pg8::gemm_phase<EpiInProj, pg8::StaticOrder, true, true>(C.lds, g, S, E);
        if (C.G == 256 && (int)blockIdx.x >= 128) {
            conv_items3(C, NCV + NCV_P7 + ((int)blockIdx.x - 128) * 3);
        }
        if (BOTH(1)) GRID_BAR();
    }

    PSTAMP(2);
    if (IN(2)) {
      for (int rep = 0; rep < REP2; ++rep) {
#ifndef NO_LRU
#ifndef REPL
#define REPL 1
#endif
        for (int rl = 0; rl < REPL; ++rl) for (int u = C.vcu; u < BATCH * NCHUNK; u += C.G) lru_pass1(C, u);
#endif
#ifndef NO_ATTN
        attn_phase(C);
#endif
      }
        if (BOTH(2)) GRID_BAR();
    }

    PSTAMP(3);
    if (IN(3)) {
        for (int rep = 0; rep < REP3; ++rep) for (int u = C.vcu; u < BATCH * NCHUNK; u += C.G) post_phase(C, u);
        if (BOTH(3)) GRID_BAR();
    }

    PSTAMP(4);
    if (IN(4)) {
        pg8::Gemm g{WSP(bf16, WS_MIX), WSP(bf16, WS_WOUT), M, DM, DM}; pg8::StaticOrder S; S.init(M, DM, C.G, (int)blockIdx.x);
        EpiRes E{C.in[0], WSP(bf16, WS_X1B), C.ws + WS_XB, C.in[16]};
        for (int rep = 0; rep < REP4; ++rep) pg8::gemm_phase<EpiRes, pg8::StaticOrder, true, true>(C.lds, g, S, E);
        if (BOTH(4)) GRID_BAR();
    }

    PSTAMP(5);
#ifdef DRY5
    if (IN(5)) { router_phase(C, true); __syncthreads(); }
#endif
    if (IN(5)) { router_phase(C); if (BOTH(5)) GRID_BAR(); }

    PSTAMP(6);

    PSTAMP(7);
    if (IN(7)) {
        build_tables(C);
        const LAS int* padstart = (const LAS int*)(C.lds + TAB_OFF); const int MT = padstart[NE] >> 8;
        pg8::Gemm g{(const bf16*)(C.ws + WS_XB), WSP(bf16, WS_WGU), M, NE * 2048, DM / 2};
        MoeGatherOrder S{MT, 8, MT * 8, C.G, (int)blockIdx.x, padstart + 40, (const LAS int*)(C.lds + TOKT_OFF)};
        fill_unit_tables(C, S);
        EpiGateUp E{C.ws + WS_HB, C.in[20], (const LAS float*)(C.lds + TOKR_OFF)};
        for (int rep = 0; rep < REP7; ++rep) pg8::gemm_phase<EpiGateUp, MoeGatherOrder, true, true, true, true>(C.lds, g, S, E);
        if (C.G == 256) {
            LAS int* qd = (LAS int*)(C.lds + P2_MISC_OFF + 2304);
            unsigned* dctr = (unsigned*)(C.ws + WS_CTL) + CW_DEFER;
            for (;;) {
                __syncthreads();
                if (C.tid == 0) qd[0] = (int)__hip_atomic_fetch_add(dctr, 1u, __ATOMIC_RELAXED, __HIP_MEMORY_SCOPE_AGENT);
                __syncthreads();
                const int idx = ((volatile LAS int*)qd)[0];
                if (idx >= NCV_P7) break;
                conv_item(C, NCV + idx);
            }
        }
        if (BOTH(7)) GRID_BAR();
    }

    PSTAMP(8);
    if (IN(8)) {
        if (!IN(7)) build_tables(C);
        const LAS int* padstart = (const LAS int*)(C.lds + TAB_OFF); const int MT = padstart[NE] >> 8;
        pg8::Gemm g{WSP(bf16, WS_HB), WSP(bf16, WS_WDN), MAXSLOT, NE * DM, DM / 2};
        MoeOrder S{MT, 4, MT * 4, C.G, (int)blockIdx.x, padstart + 40};
        EpiDown E{C.ws + WS_YS, C.in[22], WSP(float, WS_LISTG), padstart};
        for (int rep = 0; rep < REP8; ++rep) pg8::gemm_phase<EpiDown, MoeOrder, true, true, true>(C.lds, g, S, E);
        if (BOTH(8)) GRID_BAR();
    }

    PSTAMP(9);
    if (IN(9)) {
        if (!IN(7) && !IN(8)) build_tables(C);
#ifdef DRY9
        combine_phase(C, true);
#endif
        combine_phase(C);
    }
    PSTAMP(10);
#ifdef PROBE_K
    { const unsigned long long d = pr_b - pr_a, t_end = __builtin_amdgcn_s_memrealtime(); while (__builtin_amdgcn_s_memrealtime() - t_end < d) __builtin_amdgcn_s_sleep(8); }
#endif
#undef IN
#undef BOTH
#undef GRID_BAR
}

extern "C" void kernel_launch(void* const* d_in, const int* in_sizes, int n_in, void* d_out, int out_size, void* d_ws, size_t ws_size, hipStream_t stream) {
    static int grid = 0;
    if (grid == 0) {
        if (n_in != 23 || in_sizes[0] != M * DM || out_size != M * DM || ws_size < WS_END) { fprintf(stderr, "kernel_launch: unexpected shapes (n_in %d, in0 %d, out %d, ws %zu); nothing launched\n", n_in, n_in > 0 ? in_sizes[0] : -1, out_size, ws_size); grid = -1; return; }
        int dev = 0, cus = 0, per_cu = 0;
        if (hipGetDevice(&dev) != hipSuccess || hipDeviceGetAttribute(&cus, hipDeviceAttributeMultiprocessorCount, dev) != hipSuccess) { fprintf(stderr, "kernel_launch: device query failed\n"); grid = -1; return; }
        if (hipFuncSetAttribute((const void*)fwd_kernel, hipFuncAttributeMaxDynamicSharedMemorySize, LDS_BYTES) != hipSuccess) { fprintf(stderr, "kernel_launch: hipFuncSetAttribute failed\n"); grid = -1; return; }
        if (hipOccupancyMaxActiveBlocksPerMultiprocessor(&per_cu, (const void*)fwd_kernel, NWAVES * 64, LDS_BYTES) != hipSuccess || per_cu < 1) { fprintf(stderr, "kernel_launch: occupancy query reports %d workgroups per CU; nothing launched\n", per_cu); (void)hipGetLastError(); grid = -1; return; }
        grid = cus;
    }
    if (grid < 0) return;
    if (hipMemsetAsync((char*)d_ws + WS_CTL, 0, CTL_ZERO_BYTES, stream) != hipSuccess) { fprintf(stderr, "kernel_launch: hipMemsetAsync failed\n"); return; }
    Args a{};
    for (int i = 0; i < 23; ++i) a.in[i] = (const float*)d_in[i];
    a.out = (float*)d_out; a.ws = (unsigned char*)d_ws;
    for (int li = 0; li < N_LAUNCHES; ++li) {
        a.ph_lo = (N_LAUNCHES == PER_PHASE) ? li : 0; a.ph_hi = (N_LAUNCHES == PER_PHASE) ? li + 1 : PER_PHASE;
        hipLaunchKernelGGL(fwd_kernel, dim3(grid), dim3(NWAVES * 64), LDS_BYTES, stream, a);
        const hipError_t le = hipPeekAtLastError();
        if (le != hipSuccess) { fprintf(stderr, "kernel_launch: launch %d failed: %s\n", li, hipGetErrorName(le)); break; }
    }
}
```
